# Optimizing an MI355X kernel written in HIP

```python
import math
import jax, jax.numpy as jnp
from jax import lax
import numpy as np

D_MODEL = 1024
BATCH = 4
SEQ = 4096
DEPTH = 2

GRID_W = 64
CTX_LEN = 256
HEAD_DIM = 64
A_HEADS = 8
A_KV_HEADS = 2
A_GROUP = A_HEADS // A_KV_HEADS
B_HEADS = 8
NA_ROWS = 8
NA_COLS = 16
Q_BLOCK = 128
ROPE_THETA = 10000.0
MLA_HEADS = 16
MLA_Q_LORA = 768
MLA_KV_LORA = 256
MLA_NOPE_DIM = 64
MLA_ROPE_DIM = 32
MLA_V_DIM = 64
D_FF = 2816
CONV_WIDTH = 3
N_MOD = 6
EPS = 1e-6
DEEPNORM_ALPHA = (2 * DEPTH) ** 0.25
DEEPNORM_BETA = (8 * DEPTH) ** -0.25
HEAD_SCALE = HEAD_DIM ** -0.5
MLA_SCALE = (MLA_NOPE_DIM + MLA_ROPE_DIM) ** -0.5
_A_Q = A_HEADS * HEAD_DIM
_A_KV = A_KV_HEADS * HEAD_DIM
_B_W = B_HEADS * HEAD_DIM
EVEN_IN_DIM = _A_Q + 2 * _A_KV + 3 * _B_W
EVEN_SPLITS = (_A_Q, _A_Q + _A_KV, _A_Q + 2 * _A_KV, _A_Q + 2 * _A_KV + _B_W, _A_Q + 2 * _A_KV + 2 * _B_W)
EVEN_OUT_DIM = (A_HEADS + B_HEADS) * HEAD_DIM
ODD_IN_DIM = MLA_Q_LORA + MLA_KV_LORA + MLA_ROPE_DIM
ODD_OUT_DIM = MLA_HEADS * MLA_V_DIM

kernel_name = 'hybrid_gqa_natten_mla_convglu_dit'


def _layer_norm(x, g, b):
    xf = x.astype(jnp.float32)
    mu = jnp.mean(xf, axis=-1, keepdims=True)
    var = jnp.mean(jnp.square(xf - mu), axis=-1, keepdims=True)
    return ((xf - mu) * lax.rsqrt(var + EPS) * g + b).astype(x.dtype)


def _rms_norm(x, g):
    xf = x.astype(jnp.float32)
    return (xf * lax.rsqrt(jnp.mean(jnp.square(xf), axis=-1, keepdims=True) + EPS) * g).astype(x.dtype)


def _axial_rope(length, rot_dim, dtype):
    pos = jnp.arange(length, dtype=jnp.int32)
    rows = (pos // GRID_W).astype(jnp.float32)
    cols = (pos % GRID_W).astype(jnp.float32)
    axis_dim = rot_dim // 2
    inv = ROPE_THETA ** (-jnp.arange(0, axis_dim, 2, dtype=jnp.float32) / axis_dim)
    ang = jnp.concatenate([rows[:, None] * inv, cols[:, None] * inv], axis=-1)
    return jnp.cos(ang).astype(dtype), jnp.sin(ang).astype(dtype)


def _rope(x, cos, sin):
    xp = x.reshape(x.shape[:-1] + (x.shape[-1] // 2, 2))
    x1, x2 = xp[..., 0], xp[..., 1]
    return jnp.stack([x1 * cos - x2 * sin, x1 * sin + x2 * cos], axis=-1).reshape(x.shape)


def _heads(t, n, d):
    b, length, _ = t.shape
    return t.reshape(b, length, n, d).transpose(0, 2, 1, 3)


def _merge_heads(t):
    b, h, length, d = t.shape
    return t.transpose(0, 2, 1, 3).reshape(b, length, h * d)


def _dense_attention(q, k, v, kc, vc, scale):
    b, g, r, length, dk = q.shape
    nb = length // Q_BLOCK
    qb = jnp.moveaxis(q.reshape(b, g, r, nb, Q_BLOCK, dk), 3, 0)

    def one_block(qblk):
        s = jnp.concatenate([jnp.einsum('bgrqd,bgkd->bgrqk', qblk, k),
                             jnp.einsum('bgrqd,bgcd->bgrqc', qblk, kc)], axis=-1)
        p = jax.nn.softmax(s.astype(jnp.float32) * scale, axis=-1).astype(v.dtype)
        return (jnp.einsum('bgrqk,bgkd->bgrqd', p[..., :length], v)
                + jnp.einsum('bgrqc,bgcd->bgrqd', p[..., length:], vc))

    o = lax.map(one_block, qb)
    return jnp.moveaxis(o, 0, 3).reshape(b, g, r, length, -1)


def _context_attention(q, k, v, scale):
    s = jnp.einsum('bgrqd,bgkd->bgrqk', q, k).astype(jnp.float32) * scale
    p = jax.nn.softmax(s, axis=-1).astype(v.dtype)
    return jnp.einsum('bgrqk,bgkd->bgrqd', p, v)


def _neighbourhood_attention(q, k, v, kc, vc, rpb, scale):
    b, h, length, d = q.shape
    rows = length // GRID_W
    wr = min(NA_ROWS, rows)
    qg = q.reshape(b, h, rows, GRID_W, d)
    kg = k.reshape(b, h, rows, GRID_W, d)
    vg = v.reshape(b, h, rows, GRID_W, d)
    col = jnp.arange(GRID_W, dtype=jnp.int32)
    col_start = jnp.clip(col - NA_COLS // 2, 0, GRID_W - NA_COLS)
    col_idx = col_start[:, None] + jnp.arange(NA_COLS, dtype=jnp.int32)[None, :]
    col_bias = rpb[:, :, col_idx - col[:, None] + (NA_COLS - 1)].astype(jnp.float32)
    n_nb = wr * NA_COLS

    def one_row(args):
        r, q_row = args
        rs = jnp.clip(r - wr // 2, 0, rows - wr)
        k_win = lax.dynamic_slice_in_dim(kg, rs, wr, axis=2)[:, :, :, col_idx]
        v_win = lax.dynamic_slice_in_dim(vg, rs, wr, axis=2)[:, :, :, col_idx]
        row_off = rs + jnp.arange(wr, dtype=jnp.int32) - r + (NA_ROWS - 1)
        bias = col_bias[:, row_off].transpose(0, 2, 1, 3)
        s_nb = jnp.einsum('bhqd,bhrqkd->bhqrk', q_row, k_win).astype(jnp.float32) * scale + bias[None]
        s_ctx = jnp.einsum('bhqd,bhcd->bhqc', q_row, kc).astype(jnp.float32) * scale
        p = jax.nn.softmax(jnp.concatenate([s_nb.reshape(b, h, GRID_W, n_nb), s_ctx], axis=-1), axis=-1).astype(v.dtype)
        p_nb = p[..., :n_nb].reshape(b, h, GRID_W, wr, NA_COLS)
        return (jnp.einsum('bhqrk,bhrqkd->bhqd', p_nb, v_win)
                + jnp.einsum('bhqc,bhcd->bhqd', p[..., n_nb:], vc))

    out = lax.map(one_row, (jnp.arange(rows, dtype=jnp.int32), jnp.moveaxis(qg, 2, 0)))
    return jnp.moveaxis(out, 0, 2).reshape(b, h, length, d)


def _even_mixer(h, hc, w_in, q_gain, k_gain, rpb, w_out, need_ctx):
    b, length, _ = h.shape
    cos, sin = _axial_rope(length, HEAD_DIM, h.dtype)

    def project(t):
        qa, ka, va, qb, kb, vb = jnp.split(t @ w_in, EVEN_SPLITS, axis=-1)
        return (_rms_norm(_heads(qa, A_HEADS, HEAD_DIM), q_gain),
                _rms_norm(_heads(ka, A_KV_HEADS, HEAD_DIM), k_gain),
                _heads(va, A_KV_HEADS, HEAD_DIM),
                _heads(qb, B_HEADS, HEAD_DIM), _heads(kb, B_HEADS, HEAD_DIM), _heads(vb, B_HEADS, HEAD_DIM))

    qa, ka, va, qb, kb, vb = project(h)
    qac, kac, vac, qbc, kbc, vbc = project(hc)
    qa = _rope(qa, cos, sin)
    ka = _rope(ka, cos, sin)
    ya = _dense_attention(qa.reshape(b, A_KV_HEADS, A_GROUP, length, HEAD_DIM), ka, va, kac, vac,
                          HEAD_SCALE).reshape(b, A_HEADS, length, HEAD_DIM)
    yb = _neighbourhood_attention(qb, kb, vb, kbc, vbc, rpb, HEAD_SCALE)
    y = _merge_heads(jnp.concatenate([ya, yb], axis=1)) @ w_out
    yc = None
    if need_ctx:
        lc = hc.shape[1]
        yac = _context_attention(qac.reshape(b, A_KV_HEADS, A_GROUP, lc, HEAD_DIM), kac, vac,
                                 HEAD_SCALE).reshape(b, A_HEADS, lc, HEAD_DIM)
        ybc = _context_attention(qbc[:, :, None], kbc, vbc, HEAD_SCALE)[:, :, 0]
        yc = _merge_heads(jnp.concatenate([yac, ybc], axis=1)) @ w_out
    return y, yc


def _odd_mixer(h, hc, w_in, cq_gain, ckv_gain, w_uq, w_ukv, w_out, need_ctx):
    b, length, _ = h.shape
    cos, sin = _axial_rope(length, MLA_ROPE_DIM, h.dtype)

    def compress(t):
        c_q, c_kv, k_r = jnp.split(t @ w_in, (MLA_Q_LORA, MLA_Q_LORA + MLA_KV_LORA), axis=-1)
        return _rms_norm(c_q, cq_gain), _rms_norm(c_kv, ckv_gain), k_r

    def up_q(c_q):
        return jnp.split(_heads(c_q @ w_uq, MLA_HEADS, MLA_NOPE_DIM + MLA_ROPE_DIM), (MLA_NOPE_DIM,), axis=-1)

    def up_kv(c_kv, k_r):
        k_nope, v = jnp.split(_heads(c_kv @ w_ukv, MLA_HEADS, MLA_NOPE_DIM + MLA_V_DIM), (MLA_NOPE_DIM,), axis=-1)
        k_shared = jnp.broadcast_to(k_r[:, None], k_nope.shape[:-1] + (MLA_ROPE_DIM,))
        return jnp.concatenate([k_nope, k_shared], axis=-1), v

    c_q, c_kv, k_r = compress(h)
    cc_q, cc_kv, kc_r = compress(hc)
    q_nope, q_rope = up_q(c_q)
    q = jnp.concatenate([q_nope, _rope(q_rope, cos, sin)], axis=-1)
    k, v = up_kv(c_kv, _rope(k_r, cos, sin))
    kc, vc = up_kv(cc_kv, kc_r)
    y = _merge_heads(_dense_attention(q[:, :, None], k, v, kc, vc, MLA_SCALE)[:, :, 0]) @ w_out
    yc = None
    if need_ctx:
        qc = jnp.concatenate(up_q(cc_q), axis=-1)
        yc = _merge_heads(_context_attention(qc[:, :, None], kc, vc, MLA_SCALE)[:, :, 0]) @ w_out
    return y, yc


def _conv_ffn(h, w_up, conv_w, conv_b, w_down):
    gate, val = jnp.split(h @ w_up, 2, axis=-1)
    gate = lax.conv_general_dilated(gate, conv_w[:, None, :], (1,), ((CONV_WIDTH // 2, CONV_WIDTH // 2),),
                                    dimension_numbers=('NWC', 'WIO', 'NWC'), feature_group_count=D_FF) + conv_b
    return (jax.nn.silu(gate) * val) @ w_down


def _adaln(cond, w, b):
    return jnp.split(jax.nn.silu(cond) @ w + b, N_MOD, axis=-1)


def setup_inputs(seed: int = 0) -> dict:
    key = jax.random.key(seed)
    ks = iter(jax.random.split(key, 40))

    def nrm(shape, scale):
        return jax.random.normal(next(ks), shape, jnp.float32) * scale

    def gain(n):
        return 1.0 + nrm((n,), 0.1)

    d = D_MODEL
    return {
        'x': nrm((BATCH, SEQ, d), 1.0),
        'c': nrm((BATCH, d), 1.0),
        'ctx': nrm((BATCH, CTX_LEN, d), 1.0),
        'c_ctx': nrm((d,), 1.0),
        'l0_w_ada': nrm((d, N_MOD * d), 0.5 * d ** -0.5),
        'l0_b_ada': nrm((N_MOD * d,), 0.1),
        'l0_w_in': nrm((d, EVEN_IN_DIM), d ** -0.5),
        'l0_q_gain': gain(HEAD_DIM),
        'l0_k_gain': gain(HEAD_DIM),
        'l0_rpb': nrm((B_HEADS, 2 * NA_ROWS - 1, 2 * NA_COLS - 1), 0.5),
        'l0_w_out': nrm((EVEN_OUT_DIM, d), DEEPNORM_BETA * EVEN_OUT_DIM ** -0.5),
        'l0_ln1_g': gain(d),
        'l0_ln1_b': nrm((d,), 0.02),
        'l0_w_up': nrm((d, 2 * D_FF), d ** -0.5),
        'l0_conv_w': nrm((CONV_WIDTH, D_FF), CONV_WIDTH ** -0.5),
        'l0_conv_b': nrm((D_FF,), 0.02),
        'l0_w_down': nrm((D_FF, d), DEEPNORM_BETA * D_FF ** -0.5),
        'l0_ln2_g': gain(d),
        'l0_ln2_b': nrm((d,), 0.02),
        'l1_w_ada': nrm((d, N_MOD * d), 0.5 * d ** -0.5),
        'l1_b_ada': nrm((N_MOD * d,), 0.1),
        'l1_w_in': nrm((d, ODD_IN_DIM), d ** -0.5),
        'l1_cq_gain': gain(MLA_Q_LORA),
        'l1_ckv_gain': gain(MLA_KV_LORA),
        'l1_w_uq': nrm((MLA_Q_LORA, MLA_HEADS * (MLA_NOPE_DIM + MLA_ROPE_DIM)), MLA_Q_LORA ** -0.5),
        'l1_w_ukv': nrm((MLA_KV_LORA, MLA_HEADS * (MLA_NOPE_DIM + MLA_V_DIM)), MLA_KV_LORA ** -0.5),
        'l1_w_out': nrm((ODD_OUT_DIM, d), DEEPNORM_BETA * ODD_OUT_DIM ** -0.5),
        'l1_ln1_g': gain(d),
        'l1_ln1_b': nrm((d,), 0.02),
        'l1_w_up': nrm((d, 2 * D_FF), d ** -0.5),
        'l1_conv_w': nrm((CONV_WIDTH, D_FF), CONV_WIDTH ** -0.5),
        'l1_conv_b': nrm((D_FF,), 0.02),
        'l1_w_down': nrm((D_FF, d), DEEPNORM_BETA * D_FF ** -0.5),
        'l1_ln2_g': gain(d),
        'l1_ln2_b': nrm((d,), 0.02),
    }


def reference(x, c, ctx, c_ctx,
              l0_w_ada, l0_b_ada, l0_w_in, l0_q_gain, l0_k_gain, l0_rpb, l0_w_out, l0_ln1_g, l0_ln1_b,
              l0_w_up, l0_conv_w, l0_conv_b, l0_w_down, l0_ln2_g, l0_ln2_b,
              l1_w_ada, l1_b_ada, l1_w_in, l1_cq_gain, l1_ckv_gain, l1_w_uq, l1_w_ukv, l1_w_out, l1_ln1_g, l1_ln1_b,
              l1_w_up, l1_conv_w, l1_conv_b, l1_w_down, l1_ln2_g, l1_ln2_b):
    layers = (
        dict(w_ada=l0_w_ada, b_ada=l0_b_ada, w_in=l0_w_in, q_gain=l0_q_gain, k_gain=l0_k_gain, rpb=l0_rpb,
             w_out=l0_w_out, ln1_g=l0_ln1_g, ln1_b=l0_ln1_b, w_up=l0_w_up, conv_w=l0_conv_w, conv_b=l0_conv_b,
             w_down=l0_w_down, ln2_g=l0_ln2_g, ln2_b=l0_ln2_b),
        dict(w_ada=l1_w_ada, b_ada=l1_b_ada, w_in=l1_w_in, cq_gain=l1_cq_gain, ckv_gain=l1_ckv_gain,
             w_uq=l1_w_uq, w_ukv=l1_w_ukv, w_out=l1_w_out, ln1_g=l1_ln1_g, ln1_b=l1_ln1_b, w_up=l1_w_up,
             conv_w=l1_conv_w, conv_b=l1_conv_b, w_down=l1_w_down, ln2_g=l1_ln2_g, ln2_b=l1_ln2_b),
    )
    xc = ctx
    for i in range(DEPTH):
        p = layers[i]
        need_ctx = i < DEPTH - 1
        sh1, sc1, g1, sh2, sc2, g2 = [m[:, None, :] for m in _adaln(c, p['w_ada'], p['b_ada'])]
        csh1, csc1, cg1, csh2, csc2, cg2 = _adaln(c_ctx, p['w_ada'], p['b_ada'])
        h = x * (1.0 + sc1) + sh1
        hc = xc * (1.0 + csc1) + csh1
        if i % 2 == 0:
            y, yc = _even_mixer(h, hc, p['w_in'], p['q_gain'], p['k_gain'], p['rpb'], p['w_out'], need_ctx)
        else:
            y, yc = _odd_mixer(h, hc, p['w_in'], p['cq_gain'], p['ckv_gain'], p['w_uq'], p['w_ukv'],
                               p['w_out'], need_ctx)
        x = _layer_norm(DEEPNORM_ALPHA * x + g1 * y, p['ln1_g'], p['ln1_b'])
        h = x * (1.0 + sc2) + sh2
        x = _layer_norm(DEEPNORM_ALPHA * x + g2 * _conv_ffn(h, p['w_up'], p['conv_w'], p['conv_b'], p['w_down']),
                        p['ln2_g'], p['ln2_b'])
        if need_ctx:
            xc = _layer_norm(DEEPNORM_ALPHA * xc + cg1 * yc, p['ln1_g'], p['ln1_b'])
            hc = xc * (1.0 + csc2) + csh2
            xc = _layer_norm(DEEPNORM_ALPHA * xc + cg2 * _conv_ffn(hc, p['w_up'], p['conv_w'], p['conv_b'], p['w_down']),
                             p['ln2_g'], p['ln2_b'])
    return x
```

```cpp
#include <hip/hip_runtime.h>
#include <hip/hip_cooperative_groups.h>
#include <cstdio>
#include <cstdint>
namespace cg = cooperative_groups;

#define LAS __attribute__((address_space(3)))
typedef unsigned short bf16_t;
typedef short bf16x8 __attribute__((ext_vector_type(8)));
typedef float f32x4 __attribute__((ext_vector_type(4)));
typedef float f32x16 __attribute__((ext_vector_type(16)));
typedef unsigned u32x4 __attribute__((ext_vector_type(4)));
typedef unsigned u32x2 __attribute__((ext_vector_type(2)));

constexpr int D = 1024, NB = 4, SEQ = 4096, CTXL = 256, PB = SEQ + CTXL  , MT = NB * PB  ;
constexpr int N_IN0 = 2304, DFF = 2816, N_IN1P = 1280, QLORA = 768, KVLORA = 256, NQ1 = 1536, NKV1 = 2048;
constexpr float LOG2E = 1.4426950408889634f;
constexpr float QS0 = 0.125f * LOG2E;
constexpr float QS1 = 0.10206207261596575f * LOG2E;
constexpr float ALPHA = 1.4142135623730951f;
constexpr float EPSF = 1e-6f;

constexpr size_t KiB = 1024, MiB = 1048576;
constexpr size_t WS_MOD = 0;
constexpr size_t WS_ROPE0 = 256 * KiB;
constexpr size_t WS_ROPE1 = 272 * KiB;
constexpr size_t WS_BAR = 512 * KiB;
constexpr size_t WS_W_IN0 = 1 * MiB;
constexpr size_t WS_W_OUT0 = WS_W_IN0 + 4608 * KiB;
constexpr size_t WS_W_UP0 = WS_W_OUT0 + 2 * MiB;
constexpr size_t WS_W_DN0 = WS_W_UP0 + 11 * MiB;
constexpr size_t WS_W_IN1 = WS_W_DN0 + 5632 * KiB;
constexpr size_t WS_W_UQ = WS_W_IN1 + 2560 * KiB;
constexpr size_t WS_W_UKV = WS_W_UQ + 2304 * KiB;
constexpr size_t WS_W_OUT1 = WS_W_UKV + 1 * MiB;
constexpr size_t WS_W_UP1 = WS_W_OUT1 + 2 * MiB;
constexpr size_t WS_W_DN1 = WS_W_UP1 + 11 * MiB;
constexpr size_t WS_XC = 49 * MiB;
constexpr size_t WS_H = 53 * MiB + 2048;
constexpr size_t WS_BIG = 88 * MiB;
constexpr size_t WS_RAW0 = WS_BIG;
constexpr size_t WS_KVC0 = 165 * MiB;
constexpr size_t WS_O0 = 208 * MiB;
constexpr size_t WS_Y0B = 122 * MiB;
constexpr size_t WS_YB = 182 * MiB;
constexpr size_t WS_RAW1B = 131 * MiB;
constexpr size_t WS_Y0 = WS_BIG;
constexpr size_t WS_Y = 221 * MiB;
constexpr size_t WS_U = WS_BIG;
constexpr size_t WS_RAW1 = WS_BIG;
constexpr size_t WS_CQ = 214 * MiB;
constexpr size_t WS_CKV = 240 * MiB;
constexpr size_t WS_KR = 249 * MiB;
constexpr size_t WS_KV1 = 139 * MiB;
constexpr size_t WS_Q1 = WS_BIG;
constexpr size_t WS_O1 = 214 * MiB;
constexpr size_t WS_Y1 = WS_BIG;
constexpr size_t WS_END = 256 * MiB;

#ifndef REP_ATT
#define REP_ATT 1
#endif
#ifndef KS_G2
#define KS_G2 1
#endif
#ifndef KS_G4
#define KS_G4 1
#endif
#ifndef KS_G5
#define KS_G5 1
#endif
#ifndef REP_UP
#define REP_UP 1
#endif
#ifndef REP_P0
#define REP_P0 1
#endif
#ifndef REP_SYNC
#define REP_SYNC 1
#endif
#define GRID_SYNC() do { for (int rs_ = 0; rs_ < REP_SYNC; ++rs_) { XcdBarrier xb_; xb_.bar = (unsigned*)(kargs()->ws + WS_BAR); xb_.x = xb_xcc_id(); xb_.st = (volatile LAS unsigned*)(lds + XLDS_OFF + 8192) + 8; xcd_barrier(xb_); } } while (0)
#ifndef REP_GEMM
#define REP_GEMM 1
#endif
constexpr int LDS_BYTES = 147456;
constexpr int XLDS_OFF = 131072;

__device__ __forceinline__ unsigned pk_bf16(float lo, float hi) {
    typedef float f2 __attribute__((ext_vector_type(2))); typedef __bf16 b2 __attribute__((ext_vector_type(2)));
    f2 v = {lo, hi}; b2 b = __builtin_convertvector(v, b2); return __builtin_bit_cast(unsigned, b);
}
__device__ __forceinline__ float bf_lo(unsigned w) { return __uint_as_float(w << 16); }
__device__ __forceinline__ float bf_hi(unsigned w) { return __uint_as_float(w & 0xffff0000u); }
__device__ __forceinline__ float wave_sum(float v) {
#pragma unroll
    for (int o = 1; o < 64; o <<= 1) v += __shfl_xor(v, o);
    return v;
}
#define LDS_WAIT() asm volatile("s_waitcnt lgkmcnt(0)" ::: "memory")
#define DPP_UPD(old, src, ctrl) __builtin_bit_cast(float, __builtin_amdgcn_update_dpp(__builtin_bit_cast(int, (float)(old)), __builtin_bit_cast(int, (float)(src)), (ctrl), 0xf, 0xf, false))
#define DPP_ROW_SHL1 0x101
#define DPP_ROW_SHR1 0x111
#define DPP_ROW_ROR1 0x121
#define DPP_ROW_ROR15 0x12f
__device__ __forceinline__ int otid() { int t = threadIdx.x; asm volatile("" : "+v"(t)); return t; }

namespace pg8 {
constexpr int BM = 256, BK = 64, HALF = 128, HTB = HALF * BK * 2, STAGE_BYTES = 8 * HTB, NXCD = 8, WGM = 8;
__host__ __device__ __forceinline__ int lds_byte(int r, int c) { const int st = (r >> 4) * 2 + (c >> 5), rr = r & 15, cc = c & 31, ob = rr * 64 + cc * 2; return st * 1024 + (ob ^ (((ob >> 9) & 1) << 5)); }
__host__ __device__ __forceinline__ void stage_rc(int b, int& R, int& C) { const int st = b / 1024, sb = b % 1024, swz = sb ^ (((sb >> 9) & 1) << 5); R = (st >> 1) * 16 + swz / 64; C = (st & 1) * 32 + (swz % 64) / 2; }
__host__ __device__ __forceinline__ int perm32(int rho) { const int n = rho >> 4, i = rho & 15; return 8 * (i >> 2) + 4 * n + (i & 3); }

struct Unit { int pm, pn, kh; };
struct Gemm { const bf16_t* A; const bf16_t* Bt; int K; int a_rows; int kpitch; };

struct StaticOrder {
    int nM, nN, nwg, G, c, skip, nNr, u0 = 0, u1 = 0x7fffffff;
    __device__ void init(int nM_, int nN_, int G_, int c_, int skip_, int ksplit = 1) { nM = nM_; nNr = nN_; nN = nN_ * ksplit; nwg = nM * nN; G = G_; c = c_; skip = skip_; }
    __device__ bool next(int i, Unit& u) const {
        const long L = (long)u0 + (long)i * G + c; if (L >= nwg || L >= u1) return false;
        int wgid = (int)L; { const int q = nwg / NXCD, r = nwg % NXCD, xcd = wgid % NXCD, off = wgid / NXCD; wgid = (xcd < r ? xcd * (q + 1) : r * (q + 1) + (xcd - r) * q) + off; }
        const int nig = WGM * nN, gid = wgid / nig, fm = gid * WGM, gsz = (nM - fm) < WGM ? (nM - fm) : WGM;
        u.pm = fm + ((wgid % nig) % gsz); u.pn = (wgid % nig) / gsz; u.kh = u.pn / nNr; u.pn -= u.kh * nNr;
        if (skip == 1) u.pm += u.pm >> 4;
        else if (skip == 2) u.pm = 16 + 17 * u.pm;
        return true;
    }
};

template <class Epi>
__device__ __forceinline__ void gemm_phase(LAS unsigned char* lds, const Gemm g, const StaticOrder& S, const Epi& E) {
    const int tid = otid(), wid = __builtin_amdgcn_readfirstlane(tid >> 6), lane = tid & 63, wr = wid >> 2, wc = wid & 3, fr = lane & 15, fq = lane >> 4;
    const int K = g.kpitch, nt = g.K / BK;
    unsigned voffA[2], voffB[2];
#pragma unroll
    for (int i = 0; i < 2; ++i) { int R, C; stage_rc(tid * 16 + i * 8192, R, C); const int Rb = ((R & ~31) + perm32(R & 31));
        voffA[i] = (unsigned)(R * K + C) * 2u; voffB[i] = (unsigned)(Rb * K + C) * 2u; }
    const size_t kstep = (size_t)(BK * 2);
    const size_t hstep = (size_t)HALF * K * 2;
    const size_t tstepB = 2 * hstep;
    const size_t tstepA = (size_t)g.a_rows * K * 2;
    const unsigned ldsw = (unsigned)wid * 1024u;
    const int aoff = lds_byte(wr * 64 + fr, fq * 8), boff = lds_byte(wc * 32 + fr, fq * 8);
#define PG8_SA(b, h) (((b) * 2 + (h)) * HTB)
#define PG8_SB(b, h) ((4 + (b) * 2 + (h)) * HTB)
#define PG8_STAGE(bufoff, gbase, voff) do { _Pragma("unroll") for (int _i = 0; _i < 2; ++_i) \
        __builtin_amdgcn_global_load_lds((const unsigned*)((const char*)(gbase) + (voff)[_i]), (LAS unsigned*)(lds + (bufoff) + ldsw + _i * 8192), 16, 0, 0); } while (0)
#define PG8_LDA(dst, b, h) do { _Pragma("unroll") for (int m = 0; m < 4; ++m) _Pragma("unroll") for (int k = 0; k < 2; ++k) dst[m][k] = *(const LAS bf16x8*)(lds + PG8_SA(b, h) + aoff + m * 2048 + k * 1024); } while (0)
#define PG8_LDB(dst, b, h) do { _Pragma("unroll") for (int n = 0; n < 2; ++n) _Pragma("unroll") for (int k = 0; k < 2; ++k) dst[n][k] = *(const LAS bf16x8*)(lds + PG8_SB(b, h) + boff + n * 2048 + k * 1024); } while (0)
#define PG8_MMA(ai, bj, At, Bt) do { __builtin_amdgcn_s_setprio(1); _Pragma("unroll") for (int m = 0; m < 4; ++m) _Pragma("unroll") for (int n = 0; n < 2; ++n) _Pragma("unroll") for (int k = 0; k < 2; ++k) \
        acc[ai][bj][m][n] = __builtin_amdgcn_mfma_f32_16x16x32_bf16(Bt[n][k], At[m][k], acc[ai][bj][m][n], 0, 0, 0); __builtin_amdgcn_s_setprio(0); } while (0)
#define PG8_WAIT_V(n) asm volatile("s_waitcnt vmcnt(" #n ")" ::: "memory")
#define PG8_WAIT_L(n) asm volatile("s_waitcnt lgkmcnt(" #n ")" ::: "memory")
#define PG8_BAR __builtin_amdgcn_s_barrier()
#define PG8_SCHED __builtin_amdgcn_sched_barrier(0)
    Unit cur, nxt; int ui = 0;
    if (!S.next(0, cur)) return;
    f32x4 acc[2][2][4][2];
#pragma unroll
    for (int a = 0; a < 2; ++a)
#pragma unroll
        for (int b = 0; b < 2; ++b)
#pragma unroll
            for (int m = 0; m < 4; ++m)
#pragma unroll
                for (int n = 0; n < 2; ++n) acc[a][b][m][n] = (f32x4){0.f, 0.f, 0.f, 0.f};
    bf16x8 At[4][2], B0[2][2], B1[2][2];
    const size_t khstep = (size_t)g.K * 2;
    const char* cA = (const char*)g.A + (size_t)cur.pm * tstepA + cur.kh * khstep; const char* cB = (const char*)g.Bt + (size_t)cur.pn * tstepB + cur.kh * khstep;
    PG8_STAGE(PG8_SB(0, 0), cB, voffB); PG8_STAGE(PG8_SB(0, 1), cB + hstep, voffB); PG8_STAGE(PG8_SA(0, 0), cA, voffA); PG8_STAGE(PG8_SA(0, 1), cA + hstep, voffA);
    if (wr == 1) PG8_BAR;
    PG8_WAIT_V(2); PG8_BAR;
    PG8_STAGE(PG8_SB(1, 0), cB + kstep, voffB); PG8_STAGE(PG8_SA(1, 0), cA + kstep, voffA); PG8_STAGE(PG8_SB(1, 1), cB + hstep + kstep, voffB);
    PG8_WAIT_V(6); PG8_BAR;
    for (;;) {
        const bool has_next = S.next(ui + 1, nxt);
        const char* nA = has_next ? (const char*)g.A + (size_t)nxt.pm * tstepA + nxt.kh * khstep : cA; const char* nB = has_next ? (const char*)g.Bt + (size_t)nxt.pn * tstepB + nxt.kh * khstep : cB;
#pragma nounroll
        for (int t = 0; t < nt; t += 2) {
            const bool last = (t == nt - 2);
            const char* a1 = cA + (size_t)(t + 1) * kstep;
            const char* a2 = last ? nA : cA + (size_t)(t + 2) * kstep; const char* b2 = last ? nB : cB + (size_t)(t + 2) * kstep;
            const char* a3 = a2 + kstep; const char* b3 = b2 + kstep;
            PG8_LDB(B0, 0, 0); PG8_LDB(B1, 0, 1); PG8_SCHED; PG8_LDA(At, 0, 0); PG8_STAGE(PG8_SA(1, 1), a1 + hstep, voffA);
            PG8_WAIT_V(8); PG8_WAIT_L(0); PG8_BAR; PG8_MMA(0, 0, At, B0); PG8_MMA(0, 1, At, B1); PG8_BAR; PG8_SCHED;
            PG8_LDA(At, 0, 1); PG8_STAGE(PG8_SB(0, 0), b2, voffB); PG8_STAGE(PG8_SB(0, 1), b2 + hstep, voffB); PG8_STAGE(PG8_SA(0, 0), a2, voffA);
            PG8_WAIT_V(8); PG8_WAIT_L(0); PG8_BAR; PG8_MMA(1, 0, At, B0); PG8_MMA(1, 1, At, B1); PG8_BAR; PG8_SCHED;
            PG8_LDB(B0, 1, 0); PG8_LDB(B1, 1, 1); PG8_SCHED; PG8_LDA(At, 1, 0); PG8_STAGE(PG8_SA(0, 1), a2 + hstep, voffA);
            PG8_WAIT_V(8); PG8_WAIT_L(0); PG8_BAR; PG8_MMA(0, 0, At, B0); PG8_MMA(0, 1, At, B1); PG8_BAR; PG8_SCHED;
            PG8_LDA(At, 1, 1); PG8_STAGE(PG8_SB(1, 0), b3, voffB); PG8_STAGE(PG8_SB(1, 1), b3 + hstep, voffB); PG8_STAGE(PG8_SA(1, 0), a3, voffA);
            PG8_WAIT_V(8); PG8_WAIT_L(0); PG8_BAR; PG8_MMA(1, 0, At, B0); PG8_MMA(1, 1, At, B1); PG8_BAR; PG8_SCHED;
        }
        if (wr == 0) PG8_BAR;
        E(acc, cur, wr, wc, fr, fq);
        if (!has_next) break;
#pragma unroll
        for (int a = 0; a < 2; ++a)
#pragma unroll
            for (int b = 0; b < 2; ++b)
#pragma unroll
                for (int m = 0; m < 4; ++m)
#pragma unroll
                    for (int n = 0; n < 2; ++n) acc[a][b][m][n] = (f32x4){0.f, 0.f, 0.f, 0.f};
        cur = nxt; cA = nA; cB = nB; ++ui;
        if (wr == 1) PG8_BAR;
    }
    PG8_WAIT_V(0);
    PG8_BAR;
#undef PG8_SA
#undef PG8_SB
#undef PG8_STAGE
#undef PG8_LDA
#undef PG8_LDB
#undef PG8_MMA
#undef PG8_WAIT_V
#undef PG8_WAIT_L
#undef PG8_BAR
#undef PG8_SCHED
}

struct EpiStore {
    bf16_t* O; int ldc; bf16_t* O2;
    __device__ __forceinline__ void operator()(const f32x4 (&acc)[2][2][4][2], const Unit& u, int wr, int wc, int fr, int fq) const {
        asm volatile("" : "+v"(fr), "+v"(fq));
        bf16_t* tb = (u.kh ? O2 : O) + (size_t)u.pm * BM * ldc + u.pn * BM;
        const unsigned off0 = (unsigned)(wr * 64 + fr) * (unsigned)ldc + (unsigned)(wc * 32 + 8 * fq);
#pragma unroll
        for (int ai = 0; ai < 2; ++ai)
#pragma unroll
            for (int m = 0; m < 4; ++m) { const unsigned offr = off0 + (unsigned)(ai * HALF + m * 16) * (unsigned)ldc;
#pragma unroll
                for (int bj = 0; bj < 2; ++bj) { const f32x4 v0 = acc[ai][bj][m][0], v1 = acc[ai][bj][m][1];
                    u32x4 w; w.x = pk_bf16(v0[0], v0[1]); w.y = pk_bf16(v0[2], v0[3]); w.z = pk_bf16(v1[0], v1[1]); w.w = pk_bf16(v1[2], v1[3]);
                    *(u32x4*)(tb + (offr + bj * HALF)) = w; } }
    }
};

struct EpiQkv0 {
    bf16_t* RAW; bf16_t* KVC; const float* qgain; const float* kgain; const float2* rope0; LAS float* SSQ;
    __device__ __forceinline__ void operator()(const f32x4 (&acc)[2][2][4][2], const Unit& u, int wr, int wc, int fr, int fq) const {
        asm volatile("" : "+v"(fr), "+v"(fq));
        const int rowt = u.pm * BM, b = rowt / PB, p0 = rowt - b * PB; const int rl0 = wr * 64 + fr;
        const bool lat = p0 < SEQ;
        const bool need_norm = (u.pn * BM) < 640;
        if (need_norm) {
#pragma unroll
            for (int bj = 0; bj < 2; ++bj)
#pragma unroll
                for (int ai = 0; ai < 2; ++ai)
#pragma unroll
                    for (int m = 0; m < 4; ++m) { const f32x4 v0 = acc[ai][bj][m][0], v1 = acc[ai][bj][m][1];
                        float ss = (v0[0] * v0[0] + v0[1] * v0[1]) + (v0[2] * v0[2] + v0[3] * v0[3]) + (v1[0] * v1[0] + v1[1] * v1[1]) + (v1[2] * v1[2] + v1[3] * v1[3]);
                        ss += __shfl_xor(ss, 16); ss += __shfl_xor(ss, 32);
                        if (fq == 0) SSQ[(bj * 256 + ai * HALF + rl0 + m * 16) * 4 + wc] = ss; }
        }
        LDS_WAIT(); __builtin_amdgcn_s_barrier(); asm volatile("" ::: "memory");
#pragma unroll
        for (int bj = 0; bj < 2; ++bj) {
            const int cg = u.pn * BM + bj * HALF + wc * 32;
            if (cg < 640) {
                const bool isq = cg < 512; const int hh = (cg >> 5) & 1;
                const float* gn = (isq ? qgain : kgain) + 32 * hh + 8 * fq; const f32x4 g0 = *(const f32x4*)gn, g1 = *(const f32x4*)(gn + 4);
                bf16_t* tb; unsigned pitch, off0;
                if (isq) { tb = RAW + (size_t)rowt * N_IN0 + cg; pitch = N_IN0; off0 = 8 * fq; }
                else { tb = KVC + ((size_t)(b * 20 + ((cg - 512) >> 6)) * PB + p0) * 64; pitch = 64; off0 = (cg & 63) + 8 * fq; }
                const float sc = isq ? QS0 : 1.f;
#pragma unroll
                for (int ai = 0; ai < 2; ++ai)
#pragma unroll
                    for (int m = 0; m < 4; ++m) { const int rl = rl0 + ai * HALF + m * 16;
                        const float tot = SSQ[(bj * 256 + rl) * 4 + wc] + SSQ[(bj * 256 + rl) * 4 + (wc ^ 1)];
                        const float rstd = __builtin_amdgcn_rsqf(tot * (1.f / 64.f) + EPSF) ;
                        f32x4 v0 = acc[ai][bj][m][0] * rstd * g0, v1 = acc[ai][bj][m][1] * rstd * g1;
                        if (lat) { const int p = p0 + rl; const int pos = hh ? (p & 63) : (p >> 6); const float2* cs = rope0 + pos * 16 + 4 * fq;
                            const float2 c0 = cs[0], c1 = cs[1], c2 = cs[2], c3 = cs[3]; f32x4 r0, r1;
                            r0[0] = v0[0] * c0.x - v0[1] * c0.y; r0[1] = v0[0] * c0.y + v0[1] * c0.x; r0[2] = v0[2] * c1.x - v0[3] * c1.y; r0[3] = v0[2] * c1.y + v0[3] * c1.x;
                            r1[0] = v1[0] * c2.x - v1[1] * c2.y; r1[1] = v1[0] * c2.y + v1[1] * c2.x; r1[2] = v1[2] * c3.x - v1[3] * c3.y; r1[3] = v1[2] * c3.y + v1[3] * c3.x;
                            v0 = r0; v1 = r1; }
                        v0 = v0 * sc; v1 = v1 * sc;
                        u32x4 w; w.x = pk_bf16(v0[0], v0[1]); w.y = pk_bf16(v0[2], v0[3]); w.z = pk_bf16(v1[0], v1[1]); w.w = pk_bf16(v1[2], v1[3]);
                        *(u32x4*)(tb + ((unsigned)rl * pitch + off0)) = w; }
            } else {
                const bool isqb = (cg >= 768 && cg < 1280);
                bf16_t* tb; unsigned pitch, off0;
                if (isqb) { tb = RAW + (size_t)rowt * N_IN0 + cg; pitch = N_IN0; off0 = 8 * fq; }
                else { const int hc = (cg < 768) ? 2 + ((cg - 640) >> 6) : (cg < 1792 ? 4 + ((cg - 1280) >> 6) : 12 + ((cg - 1792) >> 6));
                       tb = KVC + ((size_t)(b * 20 + hc) * PB + p0) * 64; pitch = 64; off0 = (cg & 63) + 8 * fq; }
                const float sc = isqb ? QS0 : 1.f;
#pragma unroll
                for (int ai = 0; ai < 2; ++ai)
#pragma unroll
                    for (int m = 0; m < 4; ++m) { const unsigned off = (unsigned)(rl0 + ai * HALF + m * 16) * pitch + off0; const f32x4 v0 = acc[ai][bj][m][0] * sc, v1 = acc[ai][bj][m][1] * sc;
                        u32x4 w; w.x = pk_bf16(v0[0], v0[1]); w.y = pk_bf16(v0[2], v0[3]); w.z = pk_bf16(v1[0], v1[1]); w.w = pk_bf16(v1[2], v1[3]);
                        *(u32x4*)(tb + off) = w; }
            }
        }
    }
};

struct EpiHeads {
    bf16_t* KVC; int nh;
    __device__ __forceinline__ void operator()(const f32x4 (&acc)[2][2][4][2], const Unit& u, int wr, int wc, int fr, int fq) const {
        asm volatile("" : "+v"(fr), "+v"(fq));
        const int rowt = u.pm * BM, b = rowt / PB, p0 = rowt - b * PB; const int rl0 = wr * 64 + fr;
#pragma unroll
        for (int bj = 0; bj < 2; ++bj) {
            const int cg = u.pn * BM + bj * HALF + wc * 32;
            bf16_t* tb = KVC + ((size_t)(b * nh + (cg >> 6)) * PB + p0) * 64; const unsigned off0 = (cg & 63) + 8 * fq;
#pragma unroll
            for (int ai = 0; ai < 2; ++ai)
#pragma unroll
                for (int m = 0; m < 4; ++m) { const unsigned off = (unsigned)(rl0 + ai * HALF + m * 16) * 64u + off0; const f32x4 v0 = acc[ai][bj][m][0], v1 = acc[ai][bj][m][1];
                    u32x4 w; w.x = pk_bf16(v0[0], v0[1]); w.y = pk_bf16(v0[2], v0[3]); w.z = pk_bf16(v1[0], v1[1]); w.w = pk_bf16(v1[2], v1[3]);
                    *(u32x4*)(tb + off) = w; }
        }
    }
};

struct EpiUq {
    bf16_t* Q1; const float2* rope1;
    __device__ __forceinline__ void operator()(const f32x4 (&acc)[2][2][4][2], const Unit& u, int wr, int wc, int fr, int fq) const {
        asm volatile("" : "+v"(fr), "+v"(fq));
        const int row0 = u.pm * BM + wr * 64 + fr;
#pragma unroll
        for (int bj = 0; bj < 2; ++bj) {
            const int c8 = u.pn * BM + bj * HALF + wc * 32 + 8 * fq, head = c8 / 96, within = c8 - head * 96;
            const bool rp = within >= 64; const int i0 = (within - 64) >> 1;
#pragma unroll
            for (int ai = 0; ai < 2; ++ai)
#pragma unroll
                for (int m = 0; m < 4; ++m) {
                    const int row = row0 + ai * HALF + m * 16; const int b = row / PB, p = row - b * PB;
                    f32x4 v0 = acc[ai][bj][m][0], v1 = acc[ai][bj][m][1];
                    if (rp) {
                        const int pos = (i0 < 8) ? (p >> 6) : (p & 63); const float2* cs = rope1 + pos * 8 + (i0 & 7);
                        const float2 c0 = cs[0], c1 = cs[1], c2 = cs[2], c3 = cs[3];
                        f32x4 r0, r1;
                        r0[0] = v0[0] * c0.x - v0[1] * c0.y; r0[1] = v0[0] * c0.y + v0[1] * c0.x;
                        r0[2] = v0[2] * c1.x - v0[3] * c1.y; r0[3] = v0[2] * c1.y + v0[3] * c1.x;
                        r1[0] = v1[0] * c2.x - v1[1] * c2.y; r1[1] = v1[0] * c2.y + v1[1] * c2.x;
                        r1[2] = v1[2] * c3.x - v1[3] * c3.y; r1[3] = v1[2] * c3.y + v1[3] * c3.x;
                        v0 = r0; v1 = r1;
                    }
                    v0 = v0 * QS1; v1 = v1 * QS1;
                    u32x4 w; w.x = pk_bf16(v0[0], v0[1]); w.y = pk_bf16(v0[2], v0[3]); w.z = pk_bf16(v1[0], v1[1]); w.w = pk_bf16(v1[2], v1[3]);
                    *(u32x4*)(Q1 + (size_t)u.pm * BM * NQ1 + ((unsigned)(row - u.pm * BM) * (unsigned)NQ1 + (unsigned)c8)) = w;
                }
        }
    }
};

struct EpiConvGlu {
    bf16_t* U; const float* cw; const float* cb; LAS float* XB;
    __device__ __forceinline__ void operator()(const f32x4 (&acc)[2][2][4][2], const Unit& u, int wr, int wc, int fr, int fq) const {
        asm volatile("" : "+v"(fr), "+v"(fq));
        const int lane = fq * 16 + fr, fl = wc * 32 + 8 * fq;
#pragma unroll
        for (int ai = 0; ai < 2; ++ai) { const int s = 2 * ai + wr;
            if (fr == 0) {
#pragma unroll
                for (int n = 0; n < 2; ++n)
#pragma unroll
                    for (int j = 0; j < 4; ++j) XB[(s * 2 + 0) * 128 + fl + 4 * n + j] = acc[ai][0][0][n][j]; }
            if (fr == 15) {
#pragma unroll
                for (int n = 0; n < 2; ++n)
#pragma unroll
                    for (int j = 0; j < 4; ++j) XB[(s * 2 + 1) * 128 + fl + 4 * n + j] = acc[ai][0][3][n][j]; }
        }
        LDS_WAIT(); __builtin_amdgcn_s_barrier(); asm volatile("" ::: "memory");
        const int fg = u.pn * 128 + fl;
        f32x4 w0[2], w1[2], w2[2], bb[2];
#pragma unroll
        for (int n = 0; n < 2; ++n) { w0[n] = *(const f32x4*)(cw + fg + 4 * n); w1[n] = *(const f32x4*)(cw + DFF + fg + 4 * n); w2[n] = *(const f32x4*)(cw + 2 * DFF + fg + 4 * n); bb[n] = *(const f32x4*)(cb + fg + 4 * n); }
#pragma unroll
        for (int ai = 0; ai < 2; ++ai) { const int s = 2 * ai + wr;
#pragma unroll
            for (int m = 0; m < 4; ++m) {
                const int rl = ai * HALF + wr * 64 + m * 16 + fr; const int grow = u.pm * 254 - 1 + rl;
                const int p = (grow >= 0) ? (grow % PB) : -1;
                const bool first = (p == 0) || (p == SEQ), lastr = (p == SEQ - 1) || (p == PB - 1);
                unsigned ow[4];
#pragma unroll
                for (int n = 0; n < 2; ++n) {
                    const f32x4 g = acc[ai][0][m][n], v = acc[ai][1][m][n]; float r[4];
#pragma unroll
                    for (int j = 0; j < 4; ++j) {
                        float tu, td;
                        if (m > 0) tu = DPP_UPD(0.f, acc[ai][0][m > 0 ? m - 1 : 0][n][j], DPP_ROW_ROR1);
                        else tu = (s > 0) ? XB[((s > 0 ? s - 1 : 0) * 2 + 1) * 128 + fl + 4 * n + j] : 0.f;
                        float up = DPP_UPD(tu, g[j], DPP_ROW_SHR1); if (first) up = 0.f;
                        if (m < 3) td = DPP_UPD(0.f, acc[ai][0][m < 3 ? m + 1 : 3][n][j], DPP_ROW_ROR15);
                        else td = (s < 3) ? XB[((s < 3 ? s + 1 : 3) * 2 + 0) * 128 + fl + 4 * n + j] : 0.f;
                        float dn = DPP_UPD(td, g[j], DPP_ROW_SHL1); if (lastr) dn = 0.f;
                        const float gc = w0[n][j] * up + w1[n][j] * g[j] + w2[n][j] * dn + bb[n][j];
                        const float sg = gc * __builtin_amdgcn_rcpf(1.f + __expf(-gc));
                        r[j] = sg * v[j];
                    }
                    ow[2 * n] = pk_bf16(r[0], r[1]); ow[2 * n + 1] = pk_bf16(r[2], r[3]);
                }
                if (rl >= 1 && rl <= 254 && grow < MT) { u32x4 w; w.x = ow[0]; w.y = ow[1]; w.z = ow[2]; w.w = ow[3]; *(u32x4*)(U + ((size_t)(u.pm * 254) * DFF + u.pn * 128) + (unsigned)((rl - 1) * DFF + fl)) = w; }
                __builtin_amdgcn_sched_barrier(0);
            }
        }
    }
};
}

__device__ __forceinline__ u32x4 gload16(const void* p) { u32x4 r; asm volatile("global_load_dwordx4 %0, %1, off" : "=&v"(r) : "v"(p) : "memory"); return r; }
__device__ __forceinline__ float max3f(float a, float b, float c) { float r; asm("v_max3_f32 %0, %1, %2, %3" : "=v"(r) : "v"(a), "v"(b), "v"(c)); return r; }
__device__ __forceinline__ int crow(int r, int hi) { return (r & 3) + 8 * (r >> 2) + 4 * hi; }
constexpr int AT_KBUF = 8192 + 4096, AT_VBUF = 8192, AT_VOFF = 4 * AT_KBUF, AT_RPB = AT_VOFF + 4 * AT_VBUF;
typedef short v4i16 __attribute__((ext_vector_type(4)));
__device__ __forceinline__ v4i16 vtr(LAS const unsigned char* p) { return __builtin_amdgcn_ds_read_tr16_b64_v4i16((LAS v4i16*)p); }

template <int DK, bool NA>
__device__ __forceinline__ void attn_unit(LAS unsigned char* lds, const bf16_t* Qp, int qpitch, const bf16_t* Kp, int kpitch, const bf16_t* KRp,
                                          const bf16_t* Vp, int vpitch, bf16_t* Op, int ta0, int ta1, int tb0, int tb1, int r0, const float* rpbh) {
    constexpr int KS = DK / 16;
    constexpr float THR = 8.f;
    const int tid = otid(), lane = tid & 63, wid = __builtin_amdgcn_readfirstlane(tid >> 6), r32 = lane & 31, hi = lane >> 5;
    LAS float* RPB = (LAS float*)(lds + AT_RPB);
    if (NA) { for (int i = tid; i < 465; i += 512) RPB[i] = rpbh[i] * LOG2E; }
    bf16x8 qf[KS];
    { const bf16_t* qrow = Qp + (size_t)(32 * wid + r32) * qpitch + 8 * hi;
#pragma unroll
      for (int s = 0; s < KS; ++s) qf[s] = *(const bf16x8*)(qrow + 16 * s); }
    const int srow = 8 * wid + (lane >> 3);
    const bf16_t* kg = Kp + (size_t)srow * kpitch + 8 * ((lane & 7) ^ ((srow >> 1) & 7));
    const bf16_t* vg = Vp + (size_t)srow * vpitch + 8 * ((lane & 7) ^ (((srow >> 1) & 1) << 2));
    const int rrow = 16 * (wid & 3) + (lane >> 2);
    const bf16_t* krg = (DK == 96) ? (KRp + (size_t)rrow * 32 + 8 * ((lane & 3) ^ ((rrow >> 2) & 3))) : Kp;
    const int na = ta1 - ta0, nt = na + (tb1 - tb0);
#define AT_TILE(i) (((i) < na) ? ta0 + (i) : tb0 + ((i) - na))
#define AT_ACT(kt) (!NA || (kt) >= 64 || ((kt) >= rs && (kt) < rs + 8))
#define AT_GLDS(gp, ldsoff) __builtin_amdgcn_global_load_lds((const unsigned*)(gp), (LAS unsigned*)(lds + (ldsoff)), 16, 0, 0)
#define AT_DMAK(kt, sl) do { AT_GLDS(kg + (size_t)(kt) * 64 * kpitch, (sl) * AT_KBUF + wid * 1024); if (DK == 96 && wid < 4) AT_GLDS(krg + (size_t)(kt) * 64 * 32, (sl) * AT_KBUF + 8192 + wid * 1024); } while (0)
#define AT_DMAV(kt, sl) AT_GLDS(vg + (size_t)(kt) * 64 * vpitch, AT_VOFF + (sl) * AT_VBUF + wid * 1024)
    int koff[KS];
#pragma unroll
    for (int s = 0; s < KS; ++s) koff[s] = (s < 4) ? (r32 * 128 + ((((2 * s + hi) ^ ((r32 >> 1) & 7))) << 4)) : (8192 + r32 * 64 + ((((2 * (s - 4) + hi) ^ ((r32 >> 2) & 3))) << 4));
#define AT_QK(bi, d0, d1) do { LAS const unsigned char* kb_ = lds + (bi) * AT_KBUF; \
        _Pragma("unroll") for (int s = 0; s < KS; ++s) { \
            const bf16x8 k0_ = *(LAS const bf16x8*)(kb_ + koff[s]); \
            const bf16x8 k1_ = *(LAS const bf16x8*)(kb_ + koff[s] + ((s < 4) ? 4096 : 2048)); \
            if (s == 0) { d0 = __builtin_amdgcn_mfma_f32_32x32x16_bf16(k0_, qf[0], negm, 0, 0, 0); d1 = __builtin_amdgcn_mfma_f32_32x32x16_bf16(k1_, qf[0], negm, 0, 0, 0); } \
            else { d0 = __builtin_amdgcn_mfma_f32_32x32x16_bf16(k0_, qf[s], d0, 0, 0, 0); d1 = __builtin_amdgcn_mfma_f32_32x32x16_bf16(k1_, qf[s], d1, 0, 0, 0); } } } while (0)
    float m_ref = 0.f, l_run = 0.f;
    f32x16 o0, o1, negm, sA0, sA1, sB0, sB1;
#pragma unroll
    for (int r = 0; r < 16; ++r) { o0[r] = 0.f; o1[r] = 0.f; negm[r] = 0.f; }
    const int c = 32 * (wid & 1) + r32, cs = min(max(c - 8, 0), 48), rq = r0 + (wid >> 1), rs = min(max(rq - 4, 0), 56);
    const int vrow_l = 4 * (lane >> 5) + ((lane & 15) >> 2), vflip = (vrow_l >> 1) & 1, vc0 = 2 * ((lane >> 4) & 1) + ((lane & 3) >> 1);
    const int vfo0 = AT_VOFF + vrow_l * 128 + ((vc0 + 4 * (0 ^ vflip)) << 4) + 8 * (lane & 1);
    const int vfo1 = AT_VOFF + vrow_l * 128 + ((vc0 + 4 * (1 ^ vflip)) << 4) + 8 * (lane & 1);
    { const int kt0 = AT_TILE(0); AT_DMAK(kt0, 0); AT_DMAV(kt0, 0);
      if (nt > 1) { const int kt1 = AT_TILE(1); AT_DMAK(kt1, 1); AT_DMAV(kt1, 1); }
      if (nt > 2) { const int kt2 = AT_TILE(2); AT_DMAK(kt2, 2); }
      asm volatile("s_waitcnt vmcnt(0) lgkmcnt(0)" ::: "memory"); __builtin_amdgcn_s_barrier(); asm volatile("" ::: "memory");
      if (AT_ACT(kt0)) AT_QK(0, sA0, sA1); }
#define AT_STEP(C0, C1, N0, N1, I) do { \
        const int i_ = (I); const int kt = AT_TILE(i_); \
        const bool act = AT_ACT(kt), has1 = (i_ + 1 < nt); \
        const bool actn = has1 && AT_ACT(AT_TILE(has1 ? i_ + 1 : i_)); \
        if (actn) AT_QK((i_ + 1) & 3, N0, N1); \
        float dl = 0.f; bool bumped = false; \
        if (act) { \
            if (NA && kt < 64) { \
                const int ro = (kt - rq + 7) * 31 - c + 15; \
                _Pragma("unroll") for (int r = 0; r < 16; ++r) { \
                    const int kc = crow(r, hi); \
                    const bool ok0 = (kc >= cs) && (kc < cs + 16), ok1 = (kc + 32 >= cs) && (kc + 32 < cs + 16); \
                    const float b0 = RPB[min(max(ro + kc, 0), 464)], b1 = RPB[min(max(ro + kc + 32, 0), 464)];     \
                    C0[r] = ok0 ? C0[r] + b0 : -1e30f; C1[r] = ok1 ? C1[r] + b1 : -1e30f; } \
            } \
            float mxa = max3f(C0[0], C0[1], C1[0]), mxb = max3f(C0[2], C0[3], C1[1]); mxa = max3f(mxa, C1[2], C1[3]); \
            _Pragma("unroll") for (int r = 4; r < 16; r += 4) { mxa = max3f(mxa, C0[r], C0[r + 1]); mxb = max3f(mxb, C0[r + 2], C0[r + 3]); mxa = max3f(mxa, C1[r], C1[r + 1]); mxb = max3f(mxb, C1[r + 2], C1[r + 3]); } \
            float mx = max3f(mxa, mxb, mxb); mx = max3f(mx, __shfl_xor(mx, 32), mx); \
            bumped = __any(mx > THR) != 0; \
            if (bumped) { \
                dl = max3f(mx, 0.f, 0.f); m_ref += dl; \
                const float al = __builtin_amdgcn_exp2f(-dl); \
                l_run *= al; \
                _Pragma("unroll") for (int r = 0; r < 16; ++r) { C0[r] -= dl; C1[r] -= dl; o0[r] *= al; o1[r] *= al; negm[r] = -m_ref; } \
            } \
            float ra = 0.f, rb = 0.f, rc = 0.f, rd = 0.f; \
            _Pragma("unroll") for (int r = 0; r < 16; r += 2) { C0[r] = __builtin_amdgcn_exp2f(C0[r]); C1[r] = __builtin_amdgcn_exp2f(C1[r]); C0[r + 1] = __builtin_amdgcn_exp2f(C0[r + 1]); C1[r + 1] = __builtin_amdgcn_exp2f(C1[r + 1]); \
                ra += C0[r]; rb += C1[r]; rc += C0[r + 1]; rd += C1[r + 1]; } \
            l_run += (ra + rb) + (rc + rd); \
            bf16x8 pf[2][2]; \
            { u32x4 w; \
              w.x = pk_bf16(C0[0], C0[1]); w.y = pk_bf16(C0[2], C0[3]); w.z = pk_bf16(C0[4], C0[5]); w.w = pk_bf16(C0[6], C0[7]); pf[0][0] = __builtin_bit_cast(bf16x8, w); \
              w.x = pk_bf16(C0[8], C0[9]); w.y = pk_bf16(C0[10], C0[11]); w.z = pk_bf16(C0[12], C0[13]); w.w = pk_bf16(C0[14], C0[15]); pf[0][1] = __builtin_bit_cast(bf16x8, w); \
              w.x = pk_bf16(C1[0], C1[1]); w.y = pk_bf16(C1[2], C1[3]); w.z = pk_bf16(C1[4], C1[5]); w.w = pk_bf16(C1[6], C1[7]); pf[1][0] = __builtin_bit_cast(bf16x8, w); \
              w.x = pk_bf16(C1[8], C1[9]); w.y = pk_bf16(C1[10], C1[11]); w.z = pk_bf16(C1[12], C1[13]); w.w = pk_bf16(C1[14], C1[15]); pf[1][1] = __builtin_bit_cast(bf16x8, w); } \
            LAS const unsigned char* vb = lds + (i_ & 3) * AT_VBUF; \
            _Pragma("unroll") for (int blk = 0; blk < 2; ++blk) \
                _Pragma("unroll") for (int sp = 0; sp < 2; ++sp) { \
                    const int off = (32 * blk + 16 * sp) * 128; \
                    const v4i16 a0 = vtr(vb + vfo0 + off), a1 = vtr(vb + vfo0 + off + 8 * 128); \
                    const v4i16 d0 = vtr(vb + vfo1 + off), d1 = vtr(vb + vfo1 + off + 8 * 128); \
                    const bf16x8 vf0 = (bf16x8){a0[0], a0[1], a0[2], a0[3], a1[0], a1[1], a1[2], a1[3]}; \
                    const bf16x8 vf1 = (bf16x8){d0[0], d0[1], d0[2], d0[3], d1[0], d1[1], d1[2], d1[3]}; \
                    o0 = __builtin_amdgcn_mfma_f32_32x32x16_bf16(vf0, pf[blk][sp], o0, 0, 0, 0); \
                    o1 = __builtin_amdgcn_mfma_f32_32x32x16_bf16(vf1, pf[blk][sp], o1, 0, 0, 0); } \
        } \
        if (actn && bumped) { _Pragma("unroll") for (int r = 0; r < 16; ++r) { N0[r] -= dl; N1[r] -= dl; } }     \
    } while (0)
    for (int i = 0; i < nt; i += 2) {
        if (i + 3 < nt) { const int kt3 = AT_TILE(i + 3); AT_DMAK(kt3, (i + 3) & 3); AT_DMAV(kt3, (i + 3) & 3); }
        if (i + 4 < nt) { const int kt4 = AT_TILE(i + 4); AT_DMAK(kt4, (i + 4) & 3); }
        if (i + 2 < nt) { const int kt2 = AT_TILE(i + 2); AT_DMAV(kt2, (i + 2) & 3); }
        AT_STEP(sA0, sA1, sB0, sB1, i);
        if (i + 1 < nt) AT_STEP(sB0, sB1, sA0, sA1, i + 1);
        asm volatile("s_waitcnt vmcnt(0) lgkmcnt(0)" ::: "memory"); __builtin_amdgcn_s_barrier(); asm volatile("" ::: "memory");
    }
    __syncthreads();
#undef AT_STEP
#undef AT_TILE
#undef AT_ACT
#undef AT_GLDS
#undef AT_DMAK
#undef AT_DMAV
#undef AT_QK
    l_run += __shfl_xor(l_run, 32);
    const float inv = 1.f / l_run;
    bf16_t* orow = Op + (size_t)(32 * wid + r32) * 1024 + 4 * hi;
#pragma unroll
    for (int g = 0; g < 4; ++g) {
        u32x2 w0, w1;
        w0.x = pk_bf16(o0[4 * g] * inv, o0[4 * g + 1] * inv); w0.y = pk_bf16(o0[4 * g + 2] * inv, o0[4 * g + 3] * inv);
        w1.x = pk_bf16(o1[4 * g] * inv, o1[4 * g + 1] * inv); w1.y = pk_bf16(o1[4 * g + 2] * inv, o1[4 * g + 3] * inv);
        *(u32x2*)(orow + 8 * g) = w0; *(u32x2*)(orow + 32 + 8 * g) = w1;
    }
}

#define XB_TMO      128
#define XB_XCNT(j)  (256  + 64 * (j))
#define XB_XSUB(j)  (1280 + 64 * (j))
#define XB_XGEN(j)  (2304 + 64 * (j))
#define XB_TOP      3328
#define XB_TOPGEN   3392
#define XCD_BAR_WORDS 3456
#define XB_SPIN_CAP (1u << 18)
__device__ __forceinline__ unsigned xb_ld(unsigned* p)              { return __hip_atomic_load(p, __ATOMIC_RELAXED, __HIP_MEMORY_SCOPE_AGENT); }
__device__ __forceinline__ unsigned xb_add(unsigned* p, unsigned v) { return __hip_atomic_fetch_add(p, v, __ATOMIC_RELAXED, __HIP_MEMORY_SCOPE_AGENT); }
__device__ __forceinline__ unsigned xb_xcc_id() { return (unsigned)__builtin_amdgcn_s_getreg((3 << 11) | 20) & 0xFu; }
#define XB_SPIN(cond, bar) do { unsigned _sp = 0; while (cond) { __builtin_amdgcn_s_sleep(1); \
    if ((++_sp & 255u) == 0u) { if (xb_ld(&(bar)[XB_TMO])) break; if (_sp > XB_SPIN_CAP) { atomicAdd(&(bar)[XB_TMO], 1u); break; } } } } while (0)
struct XcdBarrier { unsigned* bar; unsigned x; volatile LAS unsigned* st; };
__device__ __forceinline__ void xcd_barrier_complete(unsigned* bar, unsigned x, unsigned& nloc, unsigned& nx) {
    const unsigned G = gridDim.x * gridDim.y * gridDim.z;
    unsigned sum, cnt, mine, sp = 0u;
    for (;;) {
        sum = 0u; cnt = 0u; mine = 0u;
#pragma unroll
        for (unsigned j = 0; j < 16; ++j) { const unsigned c = xb_ld(&bar[XB_XCNT(j)]); sum += c; cnt += (c > 0u) ? 1u : 0u; mine = (j == x) ? c : mine; }
        if (sum == G) break;
        __builtin_amdgcn_s_sleep(1);
        if ((++sp & 255u) == 0u) { if (xb_ld(&bar[XB_TMO])) break; if (sp > XB_SPIN_CAP) { atomicAdd(&bar[XB_TMO], 1u); break; } }
    }
    nloc = mine > 0u ? mine : 1u; nx = cnt > 0u ? cnt : 1u;
}
__device__ __forceinline__ void xcd_barrier(const XcdBarrier& b) {
    asm volatile("s_waitcnt vmcnt(0)" ::: "memory");
    __syncthreads();
    if (threadIdx.x == 0) {
        unsigned* bar = b.bar;
        __builtin_amdgcn_s_waitcnt(0);
        unsigned nloc = b.st[0], nx = b.st[1];
        if (nloc == 0u) { xcd_barrier_complete(bar, b.x, nloc, nx); b.st[0] = nloc; b.st[1] = nx; }
        const unsigned old = xb_add(&bar[XB_XSUB(b.x)], 1u);
        const unsigned gen = old / nloc;
        if (old + 1u == (gen + 1u) * nloc) {
            __builtin_amdgcn_fence(__ATOMIC_RELEASE, "agent");
            asm volatile("s_waitcnt vmcnt(0)" ::: "memory");
            const unsigned og = xb_add(&bar[XB_TOP], 1u);
            const unsigned tg = og / nx;
            if (og + 1u == (tg + 1u) * nx) xb_add(&bar[XB_TOPGEN], 1u);
            else XB_SPIN(xb_ld(&bar[XB_TOPGEN]) == tg, bar);
            __builtin_amdgcn_fence(__ATOMIC_ACQUIRE, "agent");
            xb_add(&bar[XB_XGEN(b.x)], 1u);
            asm volatile("s_waitcnt vmcnt(0)" ::: "memory");
        } else {
            XB_SPIN(xb_ld(&bar[XB_XGEN(b.x)]) == gen, bar);
            __builtin_amdgcn_fence(__ATOMIC_ACQUIRE, "agent");
            asm volatile("s_waitcnt vmcnt(0)" ::: "memory");
        }
    }
    __syncthreads();
}

__device__ __forceinline__ void sub_barrier(unsigned* cnt, unsigned n) {
    asm volatile("s_waitcnt vmcnt(0)" ::: "memory");
    __syncthreads();
    if (threadIdx.x == 0) {
        __builtin_amdgcn_fence(__ATOMIC_RELEASE, "agent");
        asm volatile("s_waitcnt vmcnt(0)" ::: "memory");
        (void)xb_add(cnt, 1u);
        unsigned sp = 0u; while (xb_ld(cnt) < n) { __builtin_amdgcn_s_sleep(1); if (++sp > (1u << 22)) break; }
        __builtin_amdgcn_fence(__ATOMIC_ACQUIRE, "agent");
        asm volatile("s_waitcnt vmcnt(0)" ::: "memory");
    }
    __syncthreads();
}

struct Params { const float* in[35]; float* out; unsigned char* ws; };

__device__ __forceinline__ void transpose_item(const float* __restrict__ W, int K, int N, bf16_t* WT, int mode, LAS float* scr, int item, int lane) {
    const int nblk = N / 32, kb = item / nblk, nb = item % nblk, k0 = 64 * kb, n0 = 32 * nb;
    float tv[32];
#pragma unroll
    for (int i = 0; i < 32; ++i) tv[i] = W[(size_t)(k0 + 2 * i + (lane >> 5)) * N + n0 + (lane & 31)];
#pragma unroll
    for (int i = 0; i < 32; ++i) scr[(2 * i + (lane >> 5)) * 33 + (lane & 31)] = tv[i];
    LDS_WAIT();
    int n0d = n0;
    if (mode == 1) { if (n0 < DFF) n0d = (n0 >> 7) * 256 + (n0 & 127); else { const int f = n0 - DFF; n0d = (f >> 7) * 256 + 128 + (f & 127); } }
    const int c = lane & 7;
#pragma unroll
    for (int j = 0; j < 4; ++j) { const int n = (lane >> 3) + 8 * j; const LAS float* s = scr + (8 * c) * 33 + n;
        u32x4 o; o.x = pk_bf16(s[0 * 33], s[1 * 33]); o.y = pk_bf16(s[2 * 33], s[3 * 33]); o.z = pk_bf16(s[4 * 33], s[5 * 33]); o.w = pk_bf16(s[6 * 33], s[7 * 33]);
        *(u32x4*)(WT + (size_t)(n0d + n) * K + k0 + 8 * c) = o; }
    LDS_WAIT();
}

__device__ __forceinline__ float* xr_row(float* out, float* xc, int b, int p) { return (p < SEQ) ? out + (size_t)(b * SEQ + p) * D : xc + (size_t)(b * CTXL + (p - SEQ)) * D; }

__device__ __forceinline__ void ln_phase(const float* src_lat, const float* src_ctx, float* out, float* xc, const bf16_t* Y, const bf16_t* Y2, const float* mod_l, int gchunk,
                                         const float* lg, const float* lb, const float* mod_next, int nchunk_sh, bf16_t* H, int mode  , int gw, int ngw, int lane) {
    constexpr int NR = 4;
    const int nrows = (mode == 0) ? NB * SEQ : (mode == 1 ? MT : NB * CTXL);
    for (int r0_ = gw; r0_ < nrows; r0_ += NR * ngw) {
        int bb[NR], pp[NR], rowi[NR], cnd[NR]; const float* srcp[NR]; bool ok[NR];
#pragma unroll
        for (int t = 0; t < NR; ++t) { ok[t] = (r0_ + t * ngw) < nrows; const int r_ = ok[t] ? r0_ + t * ngw : r0_;
            int b, p; if (mode == 0) { b = r_ >> 12; p = r_ & (SEQ - 1); } else if (mode == 1) { b = r_ / PB; p = r_ - b * PB; } else { b = r_ >> 8; p = SEQ + (r_ & (CTXL - 1)); }
            bb[t] = b; pp[t] = p; rowi[t] = b * PB + p; cnd[t] = (p < SEQ) ? b : 4;
            srcp[t] = (p < SEQ) ? src_lat + (size_t)(b * SEQ + p) * D : src_ctx + (size_t)(b * CTXL + (p - SEQ)) * D; }
        f32x4 v[NR][4]; float s[NR];
#pragma unroll
        for (int t = 0; t < NR; ++t) { const float* gv = mod_l + (size_t)cnd[t] * 6144 + gchunk * 1024; s[t] = 0.f;
#pragma unroll
            for (int j = 0; j < 4; ++j) { const int col = 4 * lane + 256 * j; const f32x4 x = *(const f32x4*)(srcp[t] + col), g = *(const f32x4*)(gv + col);
                const u32x2 yw = *(const u32x2*)(Y + (size_t)rowi[t] * D + col);
                f32x4 y; y[0] = bf_lo(yw.x); y[1] = bf_hi(yw.x); y[2] = bf_lo(yw.y); y[3] = bf_hi(yw.y);
                if (Y2) { const u32x2 zw = *(const u32x2*)(Y2 + (size_t)rowi[t] * D + col); y[0] += bf_lo(zw.x); y[1] += bf_hi(zw.x); y[2] += bf_lo(zw.y); y[3] += bf_hi(zw.y); }
                v[t][j] = x * ALPHA + g * y; s[t] += (v[t][j][0] + v[t][j][1]) + (v[t][j][2] + v[t][j][3]); } }
        float s2[NR], rstd[NR];
#pragma unroll
        for (int o = 1; o < 64; o <<= 1) {
#pragma unroll
            for (int t = 0; t < NR; ++t) s[t] += __shfl_xor(s[t], o); }
#pragma unroll
        for (int t = 0; t < NR; ++t) { const float mean = s[t] * (1.f / D); s2[t] = 0.f;
#pragma unroll
            for (int j = 0; j < 4; ++j) { v[t][j] = v[t][j] - mean; s2[t] += (v[t][j][0] * v[t][j][0] + v[t][j][1] * v[t][j][1]) + (v[t][j][2] * v[t][j][2] + v[t][j][3] * v[t][j][3]); } }
#pragma unroll
        for (int o = 1; o < 64; o <<= 1) {
#pragma unroll
            for (int t = 0; t < NR; ++t) s2[t] += __shfl_xor(s2[t], o); }
#pragma unroll
        for (int t = 0; t < NR; ++t) rstd[t] = 1.f / sqrtf(s2[t] * (1.f / D) + EPSF);
#pragma unroll
        for (int t = 0; t < NR; ++t) {
            if (ok[t]) {
                float* dst = xr_row(out, xc, bb[t], pp[t]);
#pragma unroll
                for (int j = 0; j < 4; ++j) { const int col = 4 * lane + 256 * j; const f32x4 o = v[t][j] * rstd[t] * *(const f32x4*)(lg + col) + *(const f32x4*)(lb + col);
                    *(f32x4*)(dst + col) = o;
                    if (mod_next) { const float* mn = mod_next + (size_t)cnd[t] * 6144; const f32x4 sh = *(const f32x4*)(mn + nchunk_sh * 1024 + col), sc = *(const f32x4*)(mn + (nchunk_sh + 1) * 1024 + col);
                        const f32x4 h = o * (sc + 1.f) + sh; u32x2 w; w.x = pk_bf16(h[0], h[1]); w.y = pk_bf16(h[2], h[3]); *(u32x2*)(H + (size_t)rowi[t] * D + col) = w; } }
            }
        }
    }
}

typedef const Params __attribute__((address_space(4)))* KP;
__device__ __forceinline__ KP kargs() { KP p = (KP)__builtin_amdgcn_kernarg_segment_ptr(); asm volatile("" : "+s"(p)); return p; }
__device__ __forceinline__ void convert_items(KP kp, unsigned char* ws, LAS unsigned char* lds, int lane, int wid, int lo, int hi, int wrank, int nw) {
    LAS float* scr = (LAS float*)(lds + wid * 8704);
    constexpr int I0 = 16 * 72, I1 = 16 * 32, I2 = 16 * 176, I3 = 44 * 32, I4 = 16 * 33, I5 = 12 * 48, I6 = 4 * 64;
    for (int it = lo + wrank; it < hi; it += nw) {
        int r = it;
        if (r < I0) { transpose_item(kp->in[6], 1024, N_IN0, (bf16_t*)(ws + WS_W_IN0), 0, scr, r, lane); continue; } r -= I0;
        if (r < I1) { transpose_item(kp->in[10], 1024, 1024, (bf16_t*)(ws + WS_W_OUT0), 0, scr, r, lane); continue; } r -= I1;
        if (r < I2) { transpose_item(kp->in[13], 1024, 2 * DFF, (bf16_t*)(ws + WS_W_UP0), 1, scr, r, lane); continue; } r -= I2;
        if (r < I3) { transpose_item(kp->in[16], DFF, 1024, (bf16_t*)(ws + WS_W_DN0), 0, scr, r, lane); continue; } r -= I3;
        if (r < I4) { transpose_item(kp->in[21], 1024, 1056, (bf16_t*)(ws + WS_W_IN1), 0, scr, r, lane); continue; } r -= I4;
        if (r < I5) { transpose_item(kp->in[24], QLORA, NQ1, (bf16_t*)(ws + WS_W_UQ), 0, scr, r, lane); continue; } r -= I5;
        if (r < I6) { transpose_item(kp->in[25], KVLORA, NKV1, (bf16_t*)(ws + WS_W_UKV), 0, scr, r, lane); continue; } r -= I6;
        if (r < I1) { transpose_item(kp->in[26], 1024, 1024, (bf16_t*)(ws + WS_W_OUT1), 0, scr, r, lane); continue; } r -= I1;
        if (r < I2) { transpose_item(kp->in[29], 1024, 2 * DFF, (bf16_t*)(ws + WS_W_UP1), 1, scr, r, lane); continue; } r -= I2;
        transpose_item(kp->in[32], DFF, 1024, (bf16_t*)(ws + WS_W_DN1), 0, scr, r, lane);
    }
}
constexpr int CV_L0A = 16 * 72 + 16 * 32;
constexpr int CV_L0B = CV_L0A + 16 * 176 + 44 * 32;
constexpr int CV_IN1 = CV_L0B + 16 * 33;
constexpr int CV_SMALL1 = CV_IN1 + 12 * 48 + 4 * 64 + 16 * 32;
constexpr int CV_UP1 = CV_SMALL1 + 16 * 176;
constexpr int CV_ALL = CV_UP1 + 44 * 32;
__device__ __forceinline__ void adaln_items(KP kp, unsigned char* ws, LAS unsigned char* lds, int tid, int lane, int wid, int lo, int hi, int brank, int nb) {
    float* MOD = (float*)(ws + WS_MOD);
    LAS float* SC = (LAS float*)(lds + 73728);
    LAS float* RED = (LAS float*)(lds + 73728 + 20480);
    { const float* cv = kp->in[1]; const float* ccv = kp->in[3];
      for (int i = tid; i < 5 * 1024; i += 512) { const int cnd = i >> 10, k = i & 1023; const float v = (cnd < 4) ? cv[cnd * 1024 + k] : ccv[k]; SC[i] = v / (1.f + expf(-v)); } }
    __syncthreads();
    for (int item = lo + brank; item < hi; item += nb) {
        const int l = item / 192, chunk = item % 192; const float* W = l ? kp->in[19] : kp->in[4]; const float* Bv = l ? kp->in[20] : kp->in[5];
        const int col = chunk * 32 + (lane & 31), kg16 = wid * 2 + (lane >> 5);
        float a0 = 0.f, a1 = 0.f, a2 = 0.f, a3 = 0.f, a4 = 0.f;
        for (int kb = 0; kb < 64; kb += 32) {
            float wv[32];
#pragma unroll
            for (int i = 0; i < 32; ++i) wv[i] = W[(size_t)(kg16 + 16 * (kb + i)) * 6144 + col];
#pragma unroll
            for (int i = 0; i < 32; ++i) { const int k = kg16 + 16 * (kb + i); const float w = wv[i];
                a0 += SC[k] * w; a1 += SC[1024 + k] * w; a2 += SC[2048 + k] * w; a3 += SC[3072 + k] * w; a4 += SC[4096 + k] * w; }
        }
        RED[(kg16 * 5 + 0) * 32 + (lane & 31)] = a0; RED[(kg16 * 5 + 1) * 32 + (lane & 31)] = a1; RED[(kg16 * 5 + 2) * 32 + (lane & 31)] = a2; RED[(kg16 * 5 + 3) * 32 + (lane & 31)] = a3; RED[(kg16 * 5 + 4) * 32 + (lane & 31)] = a4;
        __syncthreads();
        if (tid < 160) { const int cnd = tid >> 5, cl = tid & 31; float s = 0.f;
#pragma unroll
            for (int kg = 0; kg < 16; ++kg) s += RED[(kg * 5 + cnd) * 32 + cl];
            MOD[(size_t)(l * 5 + cnd) * 6144 + chunk * 32 + cl] = s + Bv[chunk * 32 + cl]; }
        __syncthreads();
    }
}
__device__ __forceinline__ bool idle_rank(int nwg, int G, int bx, int& rank, int& n) {
    const int cmax = (nwg + G - 1) / G, nb2 = nwg - G * (cmax - 1);
    if (nb2 >= G) { rank = bx; n = G; return true; }
    rank = bx - nb2; n = G - nb2; return bx >= nb2;
}
#define PH_BEGIN \
    const KP kp = kargs(); unsigned char* const ws = kp->ws; (void)ws; \
    const int tid = otid(), lane = tid & 63, wid = __builtin_amdgcn_readfirstlane(tid >> 6); (void)lane; \
    const int G = gridDim.x, bx = blockIdx.x, gw = bx * 8 + wid, ngw = G * 8; (void)gw; (void)ngw;

__global__ void __launch_bounds__(512) mega_fwd(Params Pdummy) {
    extern __shared__ __attribute__((aligned(16))) unsigned char lds_raw[];
    LAS unsigned char* lds = (LAS unsigned char*)lds_raw;
    cg::grid_group grid = cg::this_grid();
    { volatile LAS unsigned* MISC = (volatile LAS unsigned*)(lds + XLDS_OFF + 8192);
      if (threadIdx.x < 32) MISC[threadIdx.x] = 0u;
      __syncthreads();
      if (threadIdx.x == 0) (void)xb_add(&((unsigned*)(kargs()->ws + WS_BAR))[XB_XCNT(xb_xcc_id())], 1u); }

    for (int rep0_ = 0; rep0_ < REP_P0; ++rep0_) {
        PH_BEGIN
        float2* ROPE0 = (float2*)(ws + WS_ROPE0); float2* ROPE1 = (float2*)(ws + WS_ROPE1); bf16_t* H = (bf16_t*)(ws + WS_H);
        adaln_items(kp, ws, lds, tid, lane, wid, 0, 192, bx, G);
        for (int gt = bx * 512 + tid; gt < 1536 + 129 * 128 + 224 * 128; gt += G * 512) {
          if (gt < 1024) { const int v = gt >> 4, k = gt & 15; const float inv = exp2f(-(float)k * (13.287712379549449f / 16.f)); const float a = (float)v * inv; ROPE0[gt] = make_float2(cosf(a), sinf(a)); }
          else if (gt < 1536) { const int i = gt - 1024, v = i >> 3, k = i & 7; const float inv = exp2f(-(float)k * (13.287712379549449f / 8.f)); const float a = (float)v * inv; ROPE1[i] = make_float2(cosf(a), sinf(a)); }
          else if (gt < 1536 + 129 * 128) {
            const int zi = gt - 1536; const int zr = zi >> 7, zc = zi & 127; bf16_t* rp = (zr == 0) ? (H - D) : (H + (size_t)(MT + zr - 1) * D); *(u32x4*)(rp + zc * 8) = (u32x4){0u, 0u, 0u, 0u}; }
          else {
            const int wi = gt - 1536 - 129 * 128; bf16_t* rp = (bf16_t*)(ws + WS_W_IN1) + (size_t)1056 * 1024; *(u32x4*)(rp + (size_t)wi * 8) = (u32x4){0u, 0u, 0u, 0u}; }
        }
        convert_items(kp, ws, lds, lane, wid, 0, CV_L0A, gw, ngw);
    }
    GRID_SYNC();
    if (kargs()->ws == nullptr) grid.sync();

    {
        PH_BEGIN
        const float* MOD = (const float*)(ws + WS_MOD); bf16_t* H = (bf16_t*)(ws + WS_H); const float* xin = kp->in[0]; const float* cin = kp->in[2];
        for (int row = gw; row < MT; row += ngw) {
            const int b = row / PB, p = row - b * PB; const int cond = (p < SEQ) ? b : 4;
            const float* src = (p < SEQ) ? xin + (size_t)(b * SEQ + p) * D : cin + (size_t)(b * CTXL + (p - SEQ)) * D;
            const float* mn = MOD + (size_t)cond * 6144;
#pragma unroll
            for (int j = 0; j < 4; ++j) { const int col = 4 * lane + 256 * j; const f32x4 x = *(const f32x4*)(src + col), sh = *(const f32x4*)(mn + col), sc = *(const f32x4*)(mn + 1024 + col);
                const f32x4 h = x * (sc + 1.f) + sh; u32x2 w; w.x = pk_bf16(h[0], h[1]); w.y = pk_bf16(h[2], h[3]); *(u32x2*)(H + (size_t)row * D + col) = w; }
        }
    }
    GRID_SYNC();

    {
        PH_BEGIN
        pg8::Gemm g{(const bf16_t*)(ws + WS_H), (const bf16_t*)(ws + WS_W_IN0), 1024, 256, 1024}; pg8::StaticOrder S; S.init(MT / 256, N_IN0 / 256, G, bx, 0);
        pg8::EpiQkv0 E{(bf16_t*)(ws + WS_RAW0), (bf16_t*)(ws + WS_KVC0), kp->in[7], kp->in[8], (const float2*)(ws + WS_ROPE0), (LAS float*)(lds + XLDS_OFF)};
        for (int rep_ = 0; rep_ < REP_GEMM; ++rep_) pg8::gemm_phase<pg8::EpiQkv0>(lds, g, S, E);
        { int rk_, n_; if (idle_rank((MT / 256) * (N_IN0 / 256), G, bx, rk_, n_)) convert_items(kp, ws, lds, lane, wid, CV_L0A, CV_L0B, rk_ * 8 + wid, n_ * 8); }
    }
    GRID_SYNC();

    {
        PH_BEGIN
        const bf16_t* RAW0 = (const bf16_t*)(ws + WS_RAW0); const bf16_t* KVC0 = (const bf16_t*)(ws + WS_KVC0); bf16_t* O0 = (bf16_t*)(ws + WS_O0); const float* rpb = kp->in[9];
        for (int rep_ = 0; rep_ < REP_ATT; ++rep_)
        for (int u = ((G & 7) == 0 ? (bx & 7) * (G >> 3) + (bx >> 3) : bx); u < 1088; u += G) {
            if (u < 512 || u >= 1024) {
                const bool isctx = u >= 1024;
                int b, qcol, hk, hv, ocol; size_t qrow; int t0;
                if (!isctx) { const int qblk = u & 15, hq = (u >> 4) & 7; b = u >> 7; qcol = hq * 64; hk = hq >> 2; hv = 2 + (hq >> 2); ocol = hq * 64; qrow = (size_t)b * PB + 256 * qblk; t0 = 0; }
                else { const int v = u - 1024; const int h16 = v & 15; b = v >> 4; qcol = (h16 < 8) ? h16 * 64 : 768 + (h16 - 8) * 64; hk = (h16 < 8) ? (h16 >> 2) : 4 + (h16 - 8);
                       hv = (h16 < 8) ? 2 + (h16 >> 2) : 12 + (h16 - 8); ocol = h16 * 64; qrow = (size_t)b * PB + SEQ; t0 = 64; }
                attn_unit<64, false>(lds, RAW0 + qrow * N_IN0 + qcol, N_IN0, KVC0 + (size_t)(b * 20 + hk) * PB * 64, 64, nullptr,
                                     KVC0 + (size_t)(b * 20 + hv) * PB * 64, 64, O0 + qrow * 1024 + ocol, t0, 68, 0, 0, 0, nullptr);
            } else {
                const int v = u - 512; const int qblk = v & 15, h = (v >> 4) & 7, b = v >> 7; const size_t rowb = (size_t)b * PB;
                const int r0 = 4 * qblk, lo = min(max(r0 - 4, 0), 56), hi_ex = min(max(r0 + 3 - 4, 0), 56) + 8;
                attn_unit<64, true>(lds, RAW0 + (rowb + 256 * qblk) * N_IN0 + 768 + h * 64, N_IN0, KVC0 + (size_t)(b * 20 + 4 + h) * PB * 64, 64, nullptr,
                                    KVC0 + (size_t)(b * 20 + 12 + h) * PB * 64, 64, O0 + (rowb + 256 * qblk) * 1024 + (8 + h) * 64, 64, 68, lo, hi_ex, r0, rpb + h * 465);
            }
        }
        { const int vcu = ((G & 7) == 0 ? (bx & 7) * (G >> 3) + (bx >> 3) : bx);
          if (G >= 128) { if (vcu >= 64) { adaln_items(kp, ws, lds, tid, lane, wid, 192, 384, vcu - 64, G - 64); } }
          else { adaln_items(kp, ws, lds, tid, lane, wid, 192, 384, bx, G); } }
    }
    GRID_SYNC();

    {
        PH_BEGIN
        pg8::Gemm g{(const bf16_t*)(ws + WS_O0), (const bf16_t*)(ws + WS_W_OUT0), 1024, 256, 1024}; pg8::StaticOrder S; S.init(64, 4, G, bx, 1);
        pg8::EpiStore E{(bf16_t*)(ws + WS_Y0), 1024, nullptr};
        for (int rep_ = 0; rep_ < REP_GEMM; ++rep_) pg8::gemm_phase<pg8::EpiStore>(lds, g, S, E);
    }
    GRID_SYNC();
    {
        PH_BEGIN
        const float* MOD = (const float*)(ws + WS_MOD);
        if (G >= 64) {
            if (bx < 16) {
                pg8::Gemm g{(const bf16_t*)(ws + WS_O0), (const bf16_t*)(ws + WS_W_OUT0), 1024, 256, 1024}; pg8::StaticOrder S; S.init(4, 4, 16, bx, 2);
                pg8::EpiStore E{(bf16_t*)(ws + WS_Y0), 1024, nullptr};
                pg8::gemm_phase<pg8::EpiStore>(lds, g, S, E);
                sub_barrier((unsigned*)(ws + WS_BAR) + 3584, 16u);
                ln_phase(kp->in[0], kp->in[2], kp->out, (float*)(ws + WS_XC), (const bf16_t*)(ws + WS_Y0), nullptr, MOD, 2, kp->in[11], kp->in[12], MOD, 3, (bf16_t*)(ws + WS_H), 2, bx * 8 + wid, 16 * 8, lane);
            } else
                ln_phase(kp->in[0], kp->in[2], kp->out, (float*)(ws + WS_XC), (const bf16_t*)(ws + WS_Y0), nullptr, MOD, 2, kp->in[11], kp->in[12], MOD, 3, (bf16_t*)(ws + WS_H), 0, (bx - 16) * 8 + wid, (G - 16) * 8, lane);
        } else {
            pg8::Gemm g{(const bf16_t*)(ws + WS_O0), (const bf16_t*)(ws + WS_W_OUT0), 1024, 256, 1024}; pg8::StaticOrder S; S.init(4, 4, G, bx, 2);
            pg8::EpiStore E{(bf16_t*)(ws + WS_Y0), 1024, nullptr};
            pg8::gemm_phase<pg8::EpiStore>(lds, g, S, E);
            GRID_SYNC();
            ln_phase(kp->in[0], kp->in[2], kp->out, (float*)(ws + WS_XC), (const bf16_t*)(ws + WS_Y0), nullptr, MOD, 2, kp->in[11], kp->in[12], MOD, 3, (bf16_t*)(ws + WS_H), 1, gw, ngw, lane);
        }
    }
    GRID_SYNC();
    {
        PH_BEGIN
        pg8::Gemm g{(const bf16_t*)(ws + WS_H) - D, (const bf16_t*)(ws + WS_W_UP0), 1024, 254, 1024}; pg8::StaticOrder S; S.init(69, 22, G, bx, 0);
        pg8::EpiConvGlu E{(bf16_t*)(ws + WS_U), kp->in[14], kp->in[15], (LAS float*)(lds + XLDS_OFF)};
        for (int rep_ = 0; rep_ < REP_GEMM * REP_UP; ++rep_) pg8::gemm_phase<pg8::EpiConvGlu>(lds, g, S, E);
    }
    GRID_SYNC();
    {
        PH_BEGIN
        pg8::Gemm g{(const bf16_t*)(ws + WS_U), (const bf16_t*)(ws + WS_W_DN0), DFF, 256, DFF}; pg8::StaticOrder S; S.init(64, 4, G, bx, 1);
        pg8::EpiStore E{(bf16_t*)(ws + WS_Y), 1024, nullptr};
        for (int rep_ = 0; rep_ < REP_GEMM; ++rep_) pg8::gemm_phase<pg8::EpiStore>(lds, g, S, E);
    }
    GRID_SYNC();
    {
        PH_BEGIN
        const float* MOD = (const float*)(ws + WS_MOD); float* XC = (float*)(ws + WS_XC);
        if (G >= 64) {
            if (bx < 32) {
                pg8::Gemm g{(const bf16_t*)(ws + WS_U), (const bf16_t*)(ws + WS_W_DN0), DFF / 2, 256, DFF}; pg8::StaticOrder S; S.init(4, 4, 32, bx, 2, 2);
                pg8::EpiStore E{(bf16_t*)(ws + WS_Y), 1024, (bf16_t*)(ws + WS_YB)};
                pg8::gemm_phase<pg8::EpiStore>(lds, g, S, E);
                sub_barrier((unsigned*)(ws + WS_BAR) + 3648, 32u);
                ln_phase(kp->out, XC, kp->out, XC, (const bf16_t*)(ws + WS_Y), (const bf16_t*)(ws + WS_YB), MOD, 5, kp->in[17], kp->in[18], MOD + 5 * 6144, 0, (bf16_t*)(ws + WS_H), 2, bx * 8 + wid, 32 * 8, lane);
            } else {
                ln_phase(kp->out, XC, kp->out, XC, (const bf16_t*)(ws + WS_Y), nullptr, MOD, 5, kp->in[17], kp->in[18], MOD + 5 * 6144, 0, (bf16_t*)(ws + WS_H), 0, (bx - 32) * 8 + wid, (G - 32) * 8, lane);
                convert_items(kp, ws, lds, lane, wid, CV_L0B, CV_IN1, (bx - 32) * 8 + wid, (G - 32) * 8);
                convert_items(kp, ws, lds, lane, wid, CV_UP1, CV_ALL, (bx - 32) * 8 + wid, (G - 32) * 8);
            }
        } else {
            pg8::Gemm g{(const bf16_t*)(ws + WS_U), (const bf16_t*)(ws + WS_W_DN0), DFF / 2, 256, DFF}; pg8::StaticOrder S; S.init(4, 4, G, bx, 2, 2);
            pg8::EpiStore E{(bf16_t*)(ws + WS_Y), 1024, (bf16_t*)(ws + WS_YB)};
            pg8::gemm_phase<pg8::EpiStore>(lds, g, S, E);
            convert_items(kp, ws, lds, lane, wid, CV_L0B, CV_IN1, gw, ngw); convert_items(kp, ws, lds, lane, wid, CV_UP1, CV_ALL, gw, ngw);
            GRID_SYNC();
            ln_phase(kp->out, XC, kp->out, XC, (const bf16_t*)(ws + WS_Y), nullptr, MOD, 5, kp->in[17], kp->in[18], MOD + 5 * 6144, 0, (bf16_t*)(ws + WS_H), 0, gw, ngw, lane);
            ln_phase(kp->out, XC, kp->out, XC, (const bf16_t*)(ws + WS_Y), (const bf16_t*)(ws + WS_YB), MOD, 5, kp->in[17], kp->in[18], MOD + 5 * 6144, 0, (bf16_t*)(ws + WS_H), 2, gw, ngw, lane);
        }
    }
    GRID_SYNC();

    {
        PH_BEGIN
        pg8::Gemm g{(const bf16_t*)(ws + WS_H), (const bf16_t*)(ws + WS_W_IN1), 1024 / KS_G5, 256, 1024}; pg8::StaticOrder S; S.init(MT / 256, N_IN1P / 256, G, bx, 0, KS_G5);
        pg8::EpiStore E{(bf16_t*)(ws + WS_RAW1), N_IN1P, (bf16_t*)(ws + WS_RAW1B)};
        for (int rep_ = 0; rep_ < REP_GEMM; ++rep_) pg8::gemm_phase<pg8::EpiStore>(lds, g, S, E);
        { int rk_, n_; if (idle_rank((MT / 256) * (N_IN1P / 256) * KS_G5, G, bx, rk_, n_)) convert_items(kp, ws, lds, lane, wid, CV_IN1, CV_UP1, rk_ * 8 + wid, n_ * 8); }
    }
    GRID_SYNC();
    {
        PH_BEGIN
        const bf16_t* RAW1 = (const bf16_t*)(ws + WS_RAW1); const bf16_t* RAW1B = (const bf16_t*)(ws + WS_RAW1B); bf16_t* CQ = (bf16_t*)(ws + WS_CQ); bf16_t* CKV = (bf16_t*)(ws + WS_CKV); bf16_t* KR = (bf16_t*)(ws + WS_KR);
        const float2* ROPE1 = (const float2*)(ws + WS_ROPE1);
        const float* cqg = kp->in[22]; const float* ckvg = kp->in[23];
        for (int row = gw; row < MT; row += ngw) {
            const int b = row / PB, p = row - b * PB; const bool lat = p < SEQ;
            const bf16_t* rp = RAW1 + (size_t)row * N_IN1P; const bf16_t* rp2 = RAW1B + (size_t)row * N_IN1P; (void)rp2;
            const bf16_t* rpn = RAW1 + (size_t)((row + ngw < MT) ? row + ngw : row) * N_IN1P;
            const u32x4 pfa = *(const u32x4*)(rpn + lane * 8), pfb = *(const u32x4*)(rpn + 512 + lane * 8);
#define LD8SUM(ARR, off) float ARR[8]; { const u32x4 w_ = *(const u32x4*)(rp + (off)); const u32x4 z_ = (KS_G5 > 1) ? *(const u32x4*)(rp2 + (off)) : (u32x4){0u, 0u, 0u, 0u}; \
                ARR[0] = bf_lo(w_[0]) + bf_lo(z_[0]); ARR[1] = bf_hi(w_[0]) + bf_hi(z_[0]); ARR[2] = bf_lo(w_[1]) + bf_lo(z_[1]); ARR[3] = bf_hi(w_[1]) + bf_hi(z_[1]); \
                ARR[4] = bf_lo(w_[2]) + bf_lo(z_[2]); ARR[5] = bf_hi(w_[2]) + bf_hi(z_[2]); ARR[6] = bf_lo(w_[3]) + bf_lo(z_[3]); ARR[7] = bf_hi(w_[3]) + bf_hi(z_[3]); }
            if (lat) {
                LD8SUM(xa, lane * 8) LD8SUM(xb, 512 + (lane & 31) * 8)
                float ss = 0.f;
#pragma unroll
                for (int t = 0; t < 8; ++t) { ss += xa[t] * xa[t]; if (lane < 32) ss += xb[t] * xb[t]; }
                const float rstd = 1.f / sqrtf(wave_sum(ss) * (1.f / 768.f) + EPSF);
                { const f32x4 g0 = *(const f32x4*)(cqg + lane * 8), g1 = *(const f32x4*)(cqg + lane * 8 + 4);
                  u32x4 o; o.x = pk_bf16(xa[0] * rstd * g0[0], xa[1] * rstd * g0[1]); o.y = pk_bf16(xa[2] * rstd * g0[2], xa[3] * rstd * g0[3]);
                  o.z = pk_bf16(xa[4] * rstd * g1[0], xa[5] * rstd * g1[1]); o.w = pk_bf16(xa[6] * rstd * g1[2], xa[7] * rstd * g1[3]);
                  *(u32x4*)(CQ + (size_t)row * QLORA + lane * 8) = o; }
                if (lane < 32) { const f32x4 g0 = *(const f32x4*)(cqg + 512 + lane * 8), g1 = *(const f32x4*)(cqg + 512 + lane * 8 + 4);
                  u32x4 o; o.x = pk_bf16(xb[0] * rstd * g0[0], xb[1] * rstd * g0[1]); o.y = pk_bf16(xb[2] * rstd * g0[2], xb[3] * rstd * g0[3]);
                  o.z = pk_bf16(xb[4] * rstd * g1[0], xb[5] * rstd * g1[1]); o.w = pk_bf16(xb[6] * rstd * g1[2], xb[7] * rstd * g1[3]);
                  *(u32x4*)(CQ + (size_t)row * QLORA + 512 + lane * 8) = o; }
            }
            {
                const int l32 = lane & 31;
                LD8SUM(x, 768 + l32 * 8)
                float ss = 0.f;
#pragma unroll
                for (int t = 0; t < 8; ++t) ss += x[t] * x[t];
                const float rstd = 1.f / sqrtf(wave_sum(ss) * (0.5f / 256.f) + EPSF);
                const f32x4 g0 = *(const f32x4*)(ckvg + l32 * 8), g1 = *(const f32x4*)(ckvg + l32 * 8 + 4);
                u32x4 o; o.x = pk_bf16(x[0] * rstd * g0[0], x[1] * rstd * g0[1]); o.y = pk_bf16(x[2] * rstd * g0[2], x[3] * rstd * g0[3]);
                o.z = pk_bf16(x[4] * rstd * g1[0], x[5] * rstd * g1[1]); o.w = pk_bf16(x[6] * rstd * g1[2], x[7] * rstd * g1[3]);
                if (lane < 32) *(u32x4*)(CKV + (size_t)row * KVLORA + l32 * 8) = o;
            }
            if (lane < 4) {
                LD8SUM(x, 1024 + lane * 8)
                const int pos = (lane < 2) ? (p >> 6) : (p & 63); const int kb = (4 * lane) & 7;
                unsigned ow[4];
#pragma unroll
                for (int t = 0; t < 4; ++t) { const float2 cs = lat ? ROPE1[pos * 8 + kb + t] : make_float2(1.f, 0.f); const float x1 = x[2 * t], x2 = x[2 * t + 1];
                    ow[t] = pk_bf16(x1 * cs.x - x2 * cs.y, x1 * cs.y + x2 * cs.x); }
                *(u32x4*)(KR + (size_t)row * 32 + lane * 8) = (u32x4){ow[0], ow[1], ow[2], ow[3]};
            }
            asm volatile("" :: "v"(pfa), "v"(pfb));
        }
    }
    GRID_SYNC();
    {
        PH_BEGIN
        pg8::Gemm g{(const bf16_t*)(ws + WS_CQ), (const bf16_t*)(ws + WS_W_UQ), QLORA, 256, QLORA}; pg8::StaticOrder S; S.init(64, NQ1 / 256, G, bx, 1);
        pg8::EpiUq E{(bf16_t*)(ws + WS_Q1), (const float2*)(ws + WS_ROPE1)};
        for (int rep_ = 0; rep_ < REP_GEMM; ++rep_) pg8::gemm_phase<pg8::EpiUq>(lds, g, S, E);
    }
    {
        PH_BEGIN
        pg8::Gemm g{(const bf16_t*)(ws + WS_CKV), (const bf16_t*)(ws + WS_W_UKV), KVLORA, 256, KVLORA}; pg8::StaticOrder S;
        if ((G & 1) == 0 && G >= 64) { const int hG = G >> 1; if (bx < hG) { S.init(MT / 256, NKV1 / 256, hG, bx, 0); S.u0 = 0; S.u1 = hG; } else { S.init(MT / 256, NKV1 / 256, hG, bx - hG, 0); S.u0 = hG; } }
        else S.init(MT / 256, NKV1 / 256, G, G - 1 - bx, 0);
        pg8::EpiHeads E{(bf16_t*)(ws + WS_KV1), 32};
        for (int rep_ = 0; rep_ < REP_GEMM; ++rep_) pg8::gemm_phase<pg8::EpiHeads>(lds, g, S, E);
    }
    GRID_SYNC();
    {
        PH_BEGIN
        const bf16_t* Q1 = (const bf16_t*)(ws + WS_Q1); const bf16_t* KV1 = (const bf16_t*)(ws + WS_KV1); const bf16_t* KR = (const bf16_t*)(ws + WS_KR);
        bf16_t* O1 = (bf16_t*)(ws + WS_O1);
        for (int rep_ = 0; rep_ < REP_ATT; ++rep_)
        for (int u = ((G & 7) == 0 ? (bx & 7) * (G >> 3) + (bx >> 3) : bx); u < 1024; u += G) {
            const int qblk = u & 15, h = (u >> 4) & 15, b = u >> 8; const size_t rowb = (size_t)b * PB;
            attn_unit<96, false>(lds, Q1 + (rowb + 256 * qblk) * NQ1 + h * 96, NQ1, KV1 + (size_t)(b * 32 + 2 * h) * PB * 64, 64, KR + rowb * 32,
                                 KV1 + (size_t)(b * 32 + 2 * h + 1) * PB * 64, 64, O1 + (rowb + 256 * qblk) * 1024 + h * 64, 0, 68, 0, 0, 0, nullptr);
        }
    }
    GRID_SYNC();
    {
        PH_BEGIN
        pg8::Gemm g{(const bf16_t*)(ws + WS_O1), (const bf16_t*)(ws + WS_W_OUT1), 1024, 256, 1024}; pg8::StaticOrder S; S.init(64, 4, G, bx, 1);
        pg8::EpiStore E{(bf16_t*)(ws + WS_Y1), 1024, nullptr};
        for (int rep_ = 0; rep_ < REP_GEMM; ++rep_) pg8::gemm_phase<pg8::EpiStore>(lds, g, S, E);
    }
    GRID_SYNC();
    {
        PH_BEGIN
        const float* MOD1 = (const float*)(ws + WS_MOD) + 5 * 6144; float* XC = (float*)(ws + WS_XC);
        ln_phase(kp->out, XC, kp->out, XC, (const bf16_t*)(ws + WS_Y1), nullptr, MOD1, 2, kp->in[27], kp->in[28], MOD1, 3, (bf16_t*)(ws + WS_H), 0, gw, ngw, lane);
    }
    GRID_SYNC();
    {
        PH_BEGIN
        pg8::Gemm g{(const bf16_t*)(ws + WS_H) - D, (const bf16_t*)(ws + WS_W_UP1), 1024, 254, 1024}; pg8::StaticOrder S; S.init(69, 22, G, bx, 0);
        pg8::EpiConvGlu E{(bf16_t*)(ws + WS_U), kp->in[30], kp->in[31], (LAS float*)(lds + XLDS_OFF)};
        for (int rep_ = 0; rep_ < REP_GEMM * REP_UP; ++rep_) pg8::gemm_phase<pg8::EpiConvGlu>(lds, g, S, E);
    }
    GRID_SYNC();
    {
        PH_BEGIN
        pg8::Gemm g{(const bf16_t*)(ws + WS_U), (const bf16_t*)(ws + WS_W_DN1), DFF, 256, DFF}; pg8::StaticOrder S; S.init(64, 4, G, bx, 1);
        pg8::EpiStore E{(bf16_t*)(ws + WS_Y), 1024, nullptr};
        for (int rep_ = 0; rep_ < REP_GEMM; ++rep_) pg8::gemm_phase<pg8::EpiStore>(lds, g, S, E);
    }
    GRID_SYNC();
    {
        PH_BEGIN
        const float* MOD1 = (const float*)(ws + WS_MOD) + 5 * 6144; float* XC = (float*)(ws + WS_XC);
        ln_phase(kp->out, XC, kp->out, XC, (const bf16_t*)(ws + WS_Y), nullptr, MOD1, 5, kp->in[33], kp->in[34], nullptr, 0, (bf16_t*)(ws + WS_H), 0, gw, ngw, lane);
    }
}

extern "C" void kernel_launch(void* const* d_in, const int* in_sizes, int n_in, void* d_out, int out_size, void* d_ws, size_t ws_size, hipStream_t stream) {
    static int grid_blocks = 0;
    if (grid_blocks == 0) {
        if (n_in != 35 || ws_size < WS_END) { fprintf(stderr, "kernel_launch: unexpected n_in %d / ws %zu\n", n_in, ws_size); grid_blocks = -1; return; }
        int dev = 0, cus = 0, per_cu = 0;
        hipGetDevice(&dev);
        hipDeviceGetAttribute(&cus, hipDeviceAttributeMultiprocessorCount, dev);
        if (hipFuncSetAttribute((const void*)mega_fwd, hipFuncAttributeMaxDynamicSharedMemorySize, LDS_BYTES) != hipSuccess) { fprintf(stderr, "kernel_launch: hipFuncSetAttribute failed\n"); }
        if (hipOccupancyMaxActiveBlocksPerMultiprocessor(&per_cu, (const void*)mega_fwd, 512, LDS_BYTES) != hipSuccess || per_cu < 1) { fprintf(stderr, "kernel_launch: occupancy query gave %d\n", per_cu); per_cu = 1; }
        (void)hipGetLastError();
        if (per_cu > 1) per_cu = 1;
        grid_blocks = cus * per_cu;
    }
    if (grid_blocks < 0) return;
    Params p{};
    for (int i = 0; i < 35; ++i) p.in[i] = (const float*)d_in[i];
    p.out = (float*)d_out; p.ws = (unsigned char*)d_ws;
    if (hipMemsetAsync((unsigned char*)d_ws + WS_BAR, 0, 16 * KiB, stream) != hipSuccess) { fprintf(stderr, "kernel_launch: memset of barrier words failed\n"); return; }
    void* args[] = {&p};
    hipError_t e = hipLaunchCooperativeKernel((const void*)mega_fwd, dim3(grid_blocks), dim3(512), args, LDS_BYTES, stream);
    if (e != hipSuccess) fprintf(stderr, "cooperative launch failed: %s (grid %d)\n", hipGetErrorString(e), grid_blocks);
}
```

```cpp
#include <hip/hip_runtime.h>
#include <hip/hip_cooperative_groups.h>
#include <cstdio>
#include <cstdint>
namespace cg = cooperative_groups;

#define LAS __attribute__((address_space(3)))
typedef unsigned short bf16_t;
typedef short bf16x8 __attribute__((ext_vector_type(8)));
typedef float f32x4 __attribute__((ext_vector_type(4)));
typedef float f32x16 __attribute__((ext_vector_type(16)));
typedef unsigned u32x4 __attribute__((ext_vector_type(4)));
typedef unsigned u32x2 __attribute__((ext_vector_type(2)));

constexpr int D = 1024, NB = 4, SEQ = 4096, CTXL = 256, PB = SEQ + CTXL  , MT = NB * PB  ;
constexpr int N_IN0 = 2304, DFF = 2816, N_IN1P = 1280, QLORA = 768, KVLORA = 256, NQ1 = 1536, NKV1 = 2048;
constexpr float LOG2E = 1.4426950408889634f;
constexpr float QS0 = 0.125f * LOG2E;
constexpr float QS1 = 0.10206207261596575f * LOG2E;
constexpr float ALPHA = 1.4142135623730951f;
constexpr float EPSF = 1e-6f;

constexpr size_t KiB = 1024, MiB = 1048576;
constexpr size_t WS_MOD = 0;
constexpr size_t WS_ROPE0 = 256 * KiB;
constexpr size_t WS_ROPE1 = 272 * KiB;
constexpr size_t WS_BAR = 512 * KiB;
constexpr size_t WS_W_IN0 = 1 * MiB;
constexpr size_t WS_W_OUT0 = WS_W_IN0 + 4608 * KiB;
constexpr size_t WS_W_UP0 = WS_W_OUT0 + 2 * MiB;
constexpr size_t WS_W_DN0 = WS_W_UP0 + 11 * MiB;
constexpr size_t WS_W_IN1 = WS_W_DN0 + 5632 * KiB;
constexpr size_t WS_W_UQ = WS_W_IN1 + 2560 * KiB;
constexpr size_t WS_W_UKV = WS_W_UQ + 2304 * KiB;
constexpr size_t WS_W_OUT1 = WS_W_UKV + 1 * MiB;
constexpr size_t WS_W_UP1 = WS_W_OUT1 + 2 * MiB;
constexpr size_t WS_W_DN1 = WS_W_UP1 + 11 * MiB;
constexpr size_t WS_XC = 49 * MiB;
constexpr size_t WS_H = 53 * MiB + 2048;
constexpr size_t WS_BIG = 88 * MiB;
constexpr size_t WS_RAW0 = WS_BIG;
constexpr size_t WS_KVC0 = 165 * MiB;
constexpr size_t WS_O0 = 208 * MiB;
constexpr size_t WS_Y0B = 122 * MiB;
constexpr size_t WS_YB = 182 * MiB;
constexpr size_t WS_RAW1B = 131 * MiB;
constexpr size_t WS_Y0 = WS_BIG;
constexpr size_t WS_Y = 221 * MiB;
constexpr size_t WS_U = WS_BIG;
constexpr size_t WS_RAW1 = WS_BIG;
constexpr size_t WS_CQ = 214 * MiB;
constexpr size_t WS_CKV = 240 * MiB;
constexpr size_t WS_KR = 249 * MiB;
constexpr size_t WS_KV1 = 139 * MiB;
constexpr size_t WS_Q1 = WS_BIG;
constexpr size_t WS_O1 = 214 * MiB;
constexpr size_t WS_Y1 = WS_BIG;
constexpr size_t WS_END = 256 * MiB;

#ifndef REP_ATT
#define REP_ATT 1
#endif
#ifndef KS_G2
#define KS_G2 1
#endif
#ifndef KS_G4
#define KS_G4 1
#endif
#ifndef KS_G5
#define KS_G5 1
#endif
#ifndef REP_UP
#define REP_UP 1
#endif
#ifndef REP_P0
#define REP_P0 1
#endif
#ifndef REP_SYNC
#define REP_SYNC 1
#endif
#define GRID_SYNC() do { for (int rs_ = 0; rs_ < REP_SYNC; ++rs_) { XcdBarrier xb_; xb_.bar = (unsigned*)(kargs()->ws + WS_BAR); xb_.x = xb_xcc_id(); xb_.st = (volatile LAS unsigned*)(lds + XLDS_OFF + 8192) + 8; xcd_barrier(xb_); } } while (0)
#ifndef REP_GEMM
#define REP_GEMM 1
#endif
constexpr int LDS_BYTES = 147456;
constexpr int XLDS_OFF = 131072;

__device__ __forceinline__ unsigned pk_bf16(float lo, float hi) {
    typedef float f2 __attribute__((ext_vector_type(2))); typedef __bf16 b2 __attribute__((ext_vector_type(2)));
    f2 v = {lo, hi}; b2 b = __builtin_convertvector(v, b2); return __builtin_bit_cast(unsigned, b);
}
__device__ __forceinline__ float bf_lo(unsigned w) { return __uint_as_float(w << 16); }
__device__ __forceinline__ float bf_hi(unsigned w) { return __uint_as_float(w & 0xffff0000u); }
__device__ __forceinline__ float wave_sum(float v) {
#pragma unroll
    for (int o = 1; o < 64; o <<= 1) v += __shfl_xor(v, o);
    return v;
}
#define LDS_WAIT() asm volatile("s_waitcnt lgkmcnt(0)" ::: "memory")
#define DPP_UPD(old, src, ctrl) __builtin_bit_cast(float, __builtin_amdgcn_update_dpp(__builtin_bit_cast(int, (float)(old)), __builtin_bit_cast(int, (float)(src)), (ctrl), 0xf, 0xf, false))
#define DPP_ROW_SHL1 0x101
#define DPP_ROW_SHR1 0x111
#define DPP_ROW_ROR1 0x121
#define DPP_ROW_ROR15 0x12f
__device__ __forceinline__ int otid() { int t = threadIdx.x; asm volatile("" : "+v"(t)); return t; }

namespace pg8 {
constexpr int BM = 256, BK = 64, HALF = 128, HTB = HALF * BK * 2, STAGE_BYTES = 8 * HTB, NXCD = 8, WGM = 8;
__host__ __device__ __forceinline__ int lds_byte(int r, int c) { const int st = (r >> 4) * 2 + (c >> 5), rr = r & 15, cc = c & 31, ob = rr * 64 + cc * 2; return st * 1024 + (ob ^ (((ob >> 9) & 1) << 5)); }
__host__ __device__ __forceinline__ void stage_rc(int b, int& R, int& C) { const int st = b / 1024, sb = b % 1024, swz = sb ^ (((sb >> 9) & 1) << 5); R = (st >> 1) * 16 + swz / 64; C = (st & 1) * 32 + (swz % 64) / 2; }
__host__ __device__ __forceinline__ int perm32(int rho) { const int n = rho >> 4, i = rho & 15; return 8 * (i >> 2) + 4 * n + (i & 3); }

struct Unit { int pm, pn, kh; };
struct Gemm { const bf16_t* A; const bf16_t* Bt; int K; int a_rows; int kpitch; };

struct StaticOrder {
    int nM, nN, nwg, G, c, skip, nNr, u0 = 0, u1 = 0x7fffffff;
    __device__ void init(int nM_, int nN_, int G_, int c_, int skip_, int ksplit = 1) { nM = nM_; nNr = nN_; nN = nN_ * ksplit; nwg = nM * nN; G = G_; c = c_; skip = skip_; }
    __device__ bool next(int i, Unit& u) const {
        const long L = (long)u0 + (long)i * G + c; if (L >= nwg || L >= u1) return false;
        int wgid = (int)L; { const int q = nwg / NXCD, r = nwg % NXCD, xcd = wgid % NXCD, off = wgid / NXCD; wgid = (xcd < r ? xcd * (q + 1) : r * (q + 1) + (xcd - r) * q) + off; }
        const int nig = WGM * nN, gid = wgid / nig, fm = gid * WGM, gsz = (nM - fm) < WGM ? (nM - fm) : WGM;
        u.pm = fm + ((wgid % nig) % gsz); u.pn = (wgid % nig) / gsz; u.kh = u.pn / nNr; u.pn -= u.kh * nNr;
        if (skip == 1) u.pm += u.pm >> 4;
        else if (skip == 2) u.pm = 16 + 17 * u.pm;
        return true;
    }
};

template <class Epi>
__device__ __forceinline__ void gemm_phase(LAS unsigned char* lds, const Gemm g, const StaticOrder& S, const Epi& E) {
    const int tid = otid(), wid = __builtin_amdgcn_readfirstlane(tid >> 6), lane = tid & 63, wr = wid >> 2, wc = wid & 3, fr = lane & 15, fq = lane >> 4;
    const int K = g.kpitch, nt = g.K / BK;
    unsigned voffA[2], voffB[2];
#pragma unroll
    for (int i = 0; i < 2; ++i) { int R, C; stage_rc(tid * 16 + i * 8192, R, C); const int Rb = ((R & ~31) + perm32(R & 31));
        voffA[i] = (unsigned)(R * K + C) * 2u; voffB[i] = (unsigned)(Rb * K + C) * 2u; }
    const size_t kstep = (size_t)(BK * 2);
    const size_t hstep = (size_t)HALF * K * 2;
    const size_t tstepB = 2 * hstep;
    const size_t tstepA = (size_t)g.a_rows * K * 2;
    const unsigned ldsw = (unsigned)wid * 1024u;
    const int aoff = lds_byte(wr * 64 + fr, fq * 8), boff = lds_byte(wc * 32 + fr, fq * 8);
#define PG8_SA(b, h) (((b) * 2 + (h)) * HTB)
#define PG8_SB(b, h) ((4 + (b) * 2 + (h)) * HTB)
#define PG8_STAGE(bufoff, gbase, voff) do { _Pragma("unroll") for (int _i = 0; _i < 2; ++_i) \
        __builtin_amdgcn_global_load_lds((const unsigned*)((const char*)(gbase) + (voff)[_i]), (LAS unsigned*)(lds + (bufoff) + ldsw + _i * 8192), 16, 0, 0); } while (0)
#define PG8_LDA(dst, b, h) do { _Pragma("unroll") for (int m = 0; m < 4; ++m) _Pragma("unroll") for (int k = 0; k < 2; ++k) dst[m][k] = *(const LAS bf16x8*)(lds + PG8_SA(b, h) + aoff + m * 2048 + k * 1024); } while (0)
#define PG8_LDB(dst, b, h) do { _Pragma("unroll") for (int n = 0; n < 2; ++n) _Pragma("unroll") for (int k = 0; k < 2; ++k) dst[n][k] = *(const LAS bf16x8*)(lds + PG8_SB(b, h) + boff + n * 2048 + k * 1024); } while (0)
#define PG8_MMA(ai, bj, At, Bt) do { __builtin_amdgcn_s_setprio(1); _Pragma("unroll") for (int m = 0; m < 4; ++m) _Pragma("unroll") for (int n = 0; n < 2; ++n) _Pragma("unroll") for (int k = 0; k < 2; ++k) \
        acc[ai][bj][m][n] = __builtin_amdgcn_mfma_f32_16x16x32_bf16(Bt[n][k], At[m][k], acc[ai][bj][m][n], 0, 0, 0); __builtin_amdgcn_s_setprio(0); } while (0)
#define PG8_WAIT_V(n) asm volatile("s_waitcnt vmcnt(" #n ")" ::: "memory")
#define PG8_WAIT_L(n) asm volatile("s_waitcnt lgkmcnt(" #n ")" ::: "memory")
#define PG8_BAR __builtin_amdgcn_s_barrier()
#define PG8_SCHED __builtin_amdgcn_sched_barrier(0)
    Unit cur, nxt; int ui = 0;
    if (!S.next(0, cur)) return;
    f32x4 acc[2][2][4][2];
#pragma unroll
    for (int a = 0; a < 2; ++a)
#pragma unroll
        for (int b = 0; b < 2; ++b)
#pragma unroll
            for (int m = 0; m < 4; ++m)
#pragma unroll
                for (int n = 0; n < 2; ++n) acc[a][b][m][n] = (f32x4){0.f, 0.f, 0.f, 0.f};
    bf16x8 At[4][2], B0[2][2], B1[2][2];
    const size_t khstep = (size_t)g.K * 2;
    const char* cA = (const char*)g.A + (size_t)cur.pm * tstepA + cur.kh * khstep; const char* cB = (const char*)g.Bt + (size_t)cur.pn * tstepB + cur.kh * khstep;
    PG8_STAGE(PG8_SB(0, 0), cB, voffB); PG8_STAGE(PG8_SB(0, 1), cB + hstep, voffB); PG8_STAGE(PG8_SA(0, 0), cA, voffA); PG8_STAGE(PG8_SA(0, 1), cA + hstep, voffA);
    if (wr == 1) PG8_BAR;
    PG8_WAIT_V(2); PG8_BAR;
    PG8_STAGE(PG8_SB(1, 0), cB + kstep, voffB); PG8_STAGE(PG8_SA(1, 0), cA + kstep, voffA); PG8_STAGE(PG8_SB(1, 1), cB + hstep + kstep, voffB);
    PG8_WAIT_V(6); PG8_BAR;
    for (;;) {
        const bool has_next = S.next(ui + 1, nxt);
        const char* nA = has_next ? (const char*)g.A + (size_t)nxt.pm * tstepA + nxt.kh * khstep : cA; const char* nB = has_next ? (const char*)g.Bt + (size_t)nxt.pn * tstepB + nxt.kh * khstep : cB;
#pragma nounroll
        for (int t = 0; t < nt; t += 2) {
            const bool last = (t == nt - 2);
            const char* a1 = cA + (size_t)(t + 1) * kstep;
            const char* a2 = last ? nA : cA + (size_t)(t + 2) * kstep; const char* b2 = last ? nB : cB + (size_t)(t + 2) * kstep;
            const char* a3 = a2 + kstep; const char* b3 = b2 + kstep;
            PG8_LDB(B0, 0, 0); PG8_LDB(B1, 0, 1); PG8_SCHED; PG8_LDA(At, 0, 0); PG8_STAGE(PG8_SA(1, 1), a1 + hstep, voffA);
            PG8_WAIT_V(8); PG8_WAIT_L(0); PG8_BAR; PG8_MMA(0, 0, At, B0); PG8_MMA(0, 1, At, B1); PG8_BAR; PG8_SCHED;
            PG8_LDA(At, 0, 1); PG8_STAGE(PG8_SB(0, 0), b2, voffB); PG8_STAGE(PG8_SB(0, 1), b2 + hstep, voffB); PG8_STAGE(PG8_SA(0, 0), a2, voffA);
            PG8_WAIT_V(8); PG8_WAIT_L(0); PG8_BAR; PG8_MMA(1, 0, At, B0); PG8_MMA(1, 1, At, B1); PG8_BAR; PG8_SCHED;
            PG8_LDB(B0, 1, 0); PG8_LDB(B1, 1, 1); PG8_SCHED; PG8_LDA(At, 1, 0); PG8_STAGE(PG8_SA(0, 1), a2 + hstep, voffA);
            PG8_WAIT_V(8); PG8_WAIT_L(0); PG8_BAR; PG8_MMA(0, 0, At, B0); PG8_MMA(0, 1, At, B1); PG8_BAR; PG8_SCHED;
            PG8_LDA(At, 1, 1); PG8_STAGE(PG8_SB(1, 0), b3, voffB); PG8_STAGE(PG8_SB(1, 1), b3 + hstep, voffB); PG8_STAGE(PG8_SA(1, 0), a3, voffA);
            PG8_WAIT_V(8); PG8_WAIT_L(0); PG8_BAR; PG8_MMA(1, 0, At, B0); PG8_MMA(1, 1, At, B1); PG8_BAR; PG8_SCHED;
        }
        if (wr == 0) PG8_BAR;
        E(acc, cur, wr, wc, fr, fq);
        if (!has_next) break;
#pragma unroll
        for (int a = 0; a < 2; ++a)
#pragma unroll
            for (int b = 0; b < 2; ++b)
#pragma unroll
                for (int m = 0; m < 4; ++m)
#pragma unroll
                    for (int n = 0; n < 2; ++n) acc[a][b][m][n] = (f32x4){0.f, 0.f, 0.f, 0.f};
        cur = nxt; cA = nA; cB = nB; ++ui;
        if (wr == 1) PG8_BAR;
    }
    PG8_WAIT_V(0);
    PG8_BAR;
#undef PG8_SA
#undef PG8_SB
#undef PG8_STAGE
#undef PG8_LDA
#undef PG8_LDB
#undef PG8_MMA
#undef PG8_WAIT_V
#undef PG8_WAIT_L
#undef PG8_BAR
#undef PG8_SCHED
}

struct EpiStore {
    bf16_t* O; int ldc; bf16_t* O2;
    __device__ __forceinline__ void operator()(const f32x4 (&acc)[2][2][4][2], const Unit& u, int wr, int wc, int fr, int fq) const {
        asm volatile("" : "+v"(fr), "+v"(fq));
        bf16_t* tb = (u.kh ? O2 : O) + (size_t)u.pm * BM * ldc + u.pn * BM;
        const unsigned off0 = (unsigned)(wr * 64 + fr) * (unsigned)ldc + (unsigned)(wc * 32 + 8 * fq);
#pragma unroll
        for (int ai = 0; ai < 2; ++ai)
#pragma unroll
            for (int m = 0; m < 4; ++m) { const unsigned offr = off0 + (unsigned)(ai * HALF + m * 16) * (unsigned)ldc;
#pragma unroll
                for (int bj = 0; bj < 2; ++bj) { const f32x4 v0 = acc[ai][bj][m][0], v1 = acc[ai][bj][m][1];
                    u32x4 w; w.x = pk_bf16(v0[0], v0[1]); w.y = pk_bf16(v0[2], v0[3]); w.z = pk_bf16(v1[0], v1[1]); w.w = pk_bf16(v1[2], v1[3]);
                    *(u32x4*)(tb + (offr + bj * HALF)) = w; } }
    }
};

struct EpiQkv0 {
    bf16_t* RAW; bf16_t* KVC; const float* qgain; const float* kgain; const float2* rope0; LAS float* SSQ;
    __device__ __forceinline__ void operator()(const f32x4 (&acc)[2][2][4][2], const Unit& u, int wr, int wc, int fr, int fq) const {
        asm volatile("" : "+v"(fr), "+v"(fq));
        const int rowt = u.pm * BM, b = rowt / PB, p0 = rowt - b * PB; const int rl0 = wr * 64 + fr;
        const bool lat = p0 < SEQ;
        const bool need_norm = (u.pn * BM) < 640;
        if (need_norm) {
#pragma unroll
            for (int bj = 0; bj < 2; ++bj)
#pragma unroll
                for (int ai = 0; ai < 2; ++ai)
#pragma unroll
                    for (int m = 0; m < 4; ++m) { const f32x4 v0 = acc[ai][bj][m][0], v1 = acc[ai][bj][m][1];
                        float ss = (v0[0] * v0[0] + v0[1] * v0[1]) + (v0[2] * v0[2] + v0[3] * v0[3]) + (v1[0] * v1[0] + v1[1] * v1[1]) + (v1[2] * v1[2] + v1[3] * v1[3]);
                        ss += __shfl_xor(ss, 16); ss += __shfl_xor(ss, 32);
                        if (fq == 0) SSQ[(bj * 256 + ai * HALF + rl0 + m * 16) * 4 + wc] = ss; }
        }
        LDS_WAIT(); __builtin_amdgcn_s_barrier(); asm volatile("" ::: "memory");
#pragma unroll
        for (int bj = 0; bj < 2; ++bj) {
            const int cg = u.pn * BM + bj * HALF + wc * 32;
            if (cg < 640) {
                const bool isq = cg < 512; const int hh = (cg >> 5) & 1;
                const float* gn = (isq ? qgain : kgain) + 32 * hh + 8 * fq; const f32x4 g0 = *(const f32x4*)gn, g1 = *(const f32x4*)(gn + 4);
                bf16_t* tb; unsigned pitch, off0;
                if (isq) { tb = RAW + (size_t)rowt * N_IN0 + cg; pitch = N_IN0; off0 = 8 * fq; }
                else { tb = KVC + ((size_t)(b * 20 + ((cg - 512) >> 6)) * PB + p0) * 64; pitch = 64; off0 = (cg & 63) + 8 * fq; }
                const float sc = isq ? QS0 : 1.f;
#pragma unroll
                for (int ai = 0; ai < 2; ++ai)
#pragma unroll
                    for (int m = 0; m < 4; ++m) { const int rl = rl0 + ai * HALF + m * 16;
                        const float tot = SSQ[(bj * 256 + rl) * 4 + wc] + SSQ[(bj * 256 + rl) * 4 + (wc ^ 1)];
                        const float rstd = __builtin_amdgcn_rsqf(tot * (1.f / 64.f) + EPSF) ;
                        f32x4 v0 = acc[ai][bj][m][0] * rstd * g0, v1 = acc[ai][bj][m][1] * rstd * g1;
                        if (lat) { const int p = p0 + rl; const int pos = hh ? (p & 63) : (p >> 6); const float2* cs = rope0 + pos * 16 + 4 * fq;
                            const float2 c0 = cs[0], c1 = cs[1], c2 = cs[2], c3 = cs[3]; f32x4 r0, r1;
                            r0[0] = v0[0] * c0.x - v0[1] * c0.y; r0[1] = v0[0] * c0.y + v0[1] * c0.x; r0[2] = v0[2] * c1.x - v0[3] * c1.y; r0[3] = v0[2] * c1.y + v0[3] * c1.x;
                            r1[0] = v1[0] * c2.x - v1[1] * c2.y; r1[1] = v1[0] * c2.y + v1[1] * c2.x; r1[2] = v1[2] * c3.x - v1[3] * c3.y; r1[3] = v1[2] * c3.y + v1[3] * c3.x;
                            v0 = r0; v1 = r1; }
                        v0 = v0 * sc; v1 = v1 * sc;
                        u32x4 w; w.x = pk_bf16(v0[0], v0[1]); w.y = pk_bf16(v0[2], v0[3]); w.z = pk_bf16(v1[0], v1[1]); w.w = pk_bf16(v1[2], v1[3]);
                        *(u32x4*)(tb + ((unsigned)rl * pitch + off0)) = w; }
            } else {
                const bool isqb = (cg >= 768 && cg < 1280);
                bf16_t* tb; unsigned pitch, off0;
                if (isqb) { tb = RAW + (size_t)rowt * N_IN0 + cg; pitch = N_IN0; off0 = 8 * fq; }
                else { const int hc = (cg < 768) ? 2 + ((cg - 640) >> 6) : (cg < 1792 ? 4 + ((cg - 1280) >> 6) : 12 + ((cg - 1792) >> 6));
                       tb = KVC + ((size_t)(b * 20 + hc) * PB + p0) * 64; pitch = 64; off0 = (cg & 63) + 8 * fq; }
                const float sc = isqb ? QS0 : 1.f;
#pragma unroll
                for (int ai = 0; ai < 2; ++ai)
#pragma unroll
                    for (int m = 0; m < 4; ++m) { const unsigned off = (unsigned)(rl0 + ai * HALF + m * 16) * pitch + off0; const f32x4 v0 = acc[ai][bj][m][0] * sc, v1 = acc[ai][bj][m][1] * sc;
                        u32x4 w; w.x = pk_bf16(v0[0], v0[1]); w.y = pk_bf16(v0[2], v0[3]); w.z = pk_bf16(v1[0], v1[1]); w.w = pk_bf16(v1[2], v1[3]);
                        *(u32x4*)(tb + off) = w; }
            }
        }
    }
};

struct EpiHeads {
    bf16_t* KVC; int nh;
    __device__ __forceinline__ void operator()(const f32x4 (&acc)[2][2][4][2], const Unit& u, int wr, int wc, int fr, int fq) const {
        asm volatile("" : "+v"(fr), "+v"(fq));
        const int rowt = u.pm * BM, b = rowt / PB, p0 = rowt - b * PB; const int rl0 = wr * 64 + fr;
#pragma unroll
        for (int bj = 0; bj < 2; ++bj) {
            const int cg = u.pn * BM + bj * HALF + wc * 32;
            bf16_t* tb = KVC + ((size_t)(b * nh + (cg >> 6)) * PB + p0) * 64; const unsigned off0 = (cg & 63) + 8 * fq;
#pragma unroll
            for (int ai = 0; ai < 2; ++ai)
#pragma unroll
                for (int m = 0; m < 4; ++m) { const unsigned off = (unsigned)(rl0 + ai * HALF + m * 16) * 64u + off0; const f32x4 v0 = acc[ai][bj][m][0], v1 = acc[ai][bj][m][1];
                    u32x4 w; w.x = pk_bf16(v0[0], v0[1]); w.y = pk_bf16(v0[2], v0[3]); w.z = pk_bf16(v1[0], v1[1]); w.w = pk_bf16(v1[2], v1[3]);
                    *(u32x4*)(tb + off) = w; }
        }
    }
};

struct EpiUq {
    bf16_t* Q1; const float2* rope1;
    __device__ __forceinline__ void operator()(const f32x4 (&acc)[2][2][4][2], const Unit& u, int wr, int wc, int fr, int fq) const {
        asm volatile("" : "+v"(fr), "+v"(fq));
        const int row0 = u.pm * BM + wr * 64 + fr;
#pragma unroll
        for (int bj = 0; bj < 2; ++bj) {
            const int c8 = u.pn * BM + bj * HALF + wc * 32 + 8 * fq, head = c8 / 96, within = c8 - head * 96;
            const bool rp = within >= 64; const int i0 = (within - 64) >> 1;
#pragma unroll
            for (int ai = 0; ai < 2; ++ai)
#pragma unroll
                for (int m = 0; m < 4; ++m) {
                    const int row = row0 + ai * HALF + m * 16; const int b = row / PB, p = row - b * PB;
                    f32x4 v0 = acc[ai][bj][m][0], v1 = acc[ai][bj][m][1];
                    if (rp) {
                        const int pos = (i0 < 8) ? (p >> 6) : (p & 63); const float2* cs = rope1 + pos * 8 + (i0 & 7);
                        const float2 c0 = cs[0], c1 = cs[1], c2 = cs[2], c3 = cs[3];
                        f32x4 r0, r1;
                        r0[0] = v0[0] * c0.x - v0[1] * c0.y; r0[1] = v0[0] * c0.y + v0[1] * c0.x;
                        r0[2] = v0[2] * c1.x - v0[3] * c1.y; r0[3] = v0[2] * c1.y + v0[3] * c1.x;
                        r1[0] = v1[0] * c2.x - v1[1] * c2.y; r1[1] = v1[0] * c2.y + v1[1] * c2.x;
                        r1[2] = v1[2] * c3.x - v1[3] * c3.y; r1[3] = v1[2] * c3.y + v1[3] * c3.x;
                        v0 = r0; v1 = r1;
                    }
                    v0 = v0 * QS1; v1 = v1 * QS1;
                    u32x4 w; w.x = pk_bf16(v0[0], v0[1]); w.y = pk_bf16(v0[2], v0[3]); w.z = pk_bf16(v1[0], v1[1]); w.w = pk_bf16(v1[2], v1[3]);
                    *(u32x4*)(Q1 + (size_t)u.pm * BM * NQ1 + ((unsigned)(row - u.pm * BM) * (unsigned)NQ1 + (unsigned)c8)) = w;
                }
        }
    }
};

struct EpiConvGlu {
    bf16_t* U; const float* cw; const float* cb; LAS float* XB;
    __device__ __forceinline__ void operator()(const f32x4 (&acc)[2][2][4][2], const Unit& u, int wr, int wc, int fr, int fq) const {
        asm volatile("" : "+v"(fr), "+v"(fq));
        const int lane = fq * 16 + fr, fl = wc * 32 + 8 * fq;
#pragma unroll
        for (int ai = 0; ai < 2; ++ai) { const int s = 2 * ai + wr;
            if (fr == 0) {
#pragma unroll
                for (int n = 0; n < 2; ++n)
#pragma unroll
                    for (int j = 0; j < 4; ++j) XB[(s * 2 + 0) * 128 + fl + 4 * n + j] = acc[ai][0][0][n][j]; }
            if (fr == 15) {
#pragma unroll
                for (int n = 0; n < 2; ++n)
#pragma unroll
                    for (int j = 0; j < 4; ++j) XB[(s * 2 + 1) * 128 + fl + 4 * n + j] = acc[ai][0][3][n][j]; }
        }
        LDS_WAIT(); __builtin_amdgcn_s_barrier(); asm volatile("" ::: "memory");
        const int fg = u.pn * 128 + fl;
        f32x4 w0[2], w1[2], w2[2], bb[2];
#pragma unroll
        for (int n = 0; n < 2; ++n) { w0[n] = *(const f32x4*)(cw + fg + 4 * n); w1[n] = *(const f32x4*)(cw + DFF + fg + 4 * n); w2[n] = *(const f32x4*)(cw + 2 * DFF + fg + 4 * n); bb[n] = *(const f32x4*)(cb + fg + 4 * n); }
#pragma unroll
        for (int ai = 0; ai < 2; ++ai) { const int s = 2 * ai + wr;
#pragma unroll
            for (int m = 0; m < 4; ++m) {
                const int rl = ai * HALF + wr * 64 + m * 16 + fr; const int grow = u.pm * 254 - 1 + rl;
                const int p = (grow >= 0) ? (grow % PB) : -1;
                const bool first = (p == 0) || (p == SEQ), lastr = (p == SEQ - 1) || (p == PB - 1);
                unsigned ow[4];
#pragma unroll
                for (int n = 0; n < 2; ++n) {
                    const f32x4 g = acc[ai][0][m][n], v = acc[ai][1][m][n]; float r[4];
#pragma unroll
                    for (int j = 0; j < 4; ++j) {
                        float tu, td;
                        if (m > 0) tu = DPP_UPD(0.f, acc[ai][0][m > 0 ? m - 1 : 0][n][j], DPP_ROW_ROR1);
                        else tu = (s > 0) ? XB[((s > 0 ? s - 1 : 0) * 2 + 1) * 128 + fl + 4 * n + j] : 0.f;
                        float up = DPP_UPD(tu, g[j], DPP_ROW_SHR1); if (first) up = 0.f;
                        if (m < 3) td = DPP_UPD(0.f, acc[ai][0][m < 3 ? m + 1 : 3][n][j], DPP_ROW_ROR15);
                        else td = (s < 3) ? XB[((s < 3 ? s + 1 : 3) * 2 + 0) * 128 + fl + 4 * n + j] : 0.f;
                        float dn = DPP_UPD(td, g[j], DPP_ROW_SHL1); if (lastr) dn = 0.f;
                        const float gc = w0[n][j] * up + w1[n][j] * g[j] + w2[n][j] * dn + bb[n][j];
                        const float sg = gc * __builtin_amdgcn_rcpf(1.f + __expf(-gc));
                        r[j] = sg * v[j];
                    }
                    ow[2 * n] = pk_bf16(r[0], r[1]); ow[2 * n + 1] = pk_bf16(r[2], r[3]);
                }
                if (rl >= 1 && rl <= 254 && grow < MT) { u32x4 w; w.x = ow[0]; w.y = ow[1]; w.z = ow[2]; w.w = ow[3]; *(u32x4*)(U + ((size_t)(u.pm * 254) * DFF + u.pn * 128) + (unsigned)((rl - 1) * DFF + fl)) = w; }
                __builtin_amdgcn_sched_barrier(0);
            }
        }
    }
};
}

__device__ __forceinline__ u32x4 gload16(const void* p) { u32x4 r; asm volatile("global_load_dwordx4 %0, %1, off" : "=&v"(r) : "v"(p) : "memory"); return r; }
__device__ __forceinline__ float max3f(float a, float b, float c) { float r; asm("v_max3_f32 %0, %1, %2, %3" : "=v"(r) : "v"(a), "v"(b), "v"(c)); return r; }
__device__ __forceinline__ int crow(int r, int hi) { return (r & 3) + 8 * (r >> 2) + 4 * hi; }
constexpr int AT_KBUF = 8192 + 4096, AT_VBUF = 8192, AT_VOFF = 4 * AT_KBUF, AT_RPB = AT_VOFF + 4 * AT_VBUF;
typedef short v4i16 __attribute__((ext_vector_type(4)));
__device__ __forceinline__ v4i16 vtr(LAS const unsigned char* p) { return __builtin_amdgcn_ds_read_tr16_b64_v4i16((LAS v4i16*)p); }

template <int DK, bool NA>
__device__ __forceinline__ void attn_unit(LAS unsigned char* lds, const bf16_t* Qp, int qpitch, const bf16_t* Kp, int kpitch, const bf16_t* KRp,
                                          const bf16_t* Vp, int vpitch, bf16_t* Op, int ta0, int ta1, int tb0, int tb1, int r0, const float* rpbh) {
    constexpr int KS = DK / 16;
    constexpr float THR = 8.f;
    const int tid = otid(), lane = tid & 63, wid = __builtin_amdgcn_readfirstlane(tid >> 6), r32 = lane & 31, hi = lane >> 5;
    LAS float* RPB = (LAS float*)(lds + AT_RPB);
    if (NA) { for (int i = tid; i < 465; i += 512) RPB[i] = rpbh[i] * LOG2E; }
    bf16x8 qf[KS];
    { const bf16_t* qrow = Qp + (size_t)(32 * wid + r32) * qpitch + 8 * hi;
#pragma unroll
      for (int s = 0; s < KS; ++s) qf[s] = *(const bf16x8*)(qrow + 16 * s); }
    const int srow = 8 * wid + (lane >> 3);
    const bf16_t* kg = Kp + (size_t)srow * kpitch + 8 * ((lane & 7) ^ ((srow >> 1) & 7));
    const bf16_t* vg = Vp + (size_t)srow * vpitch + 8 * ((lane & 7) ^ (((srow >> 1) & 1) << 2));
    const int rrow = 16 * (wid & 3) + (lane >> 2);
    const bf16_t* krg = (DK == 96) ? (KRp + (size_t)rrow * 32 + 8 * ((lane & 3) ^ ((rrow >> 2) & 3))) : Kp;
    const int na = ta1 - ta0, nt = na + (tb1 - tb0);
#define AT_TILE(i) (((i) < na) ? ta0 + (i) : tb0 + ((i) - na))
#define AT_ACT(kt) (!NA || (kt) >= 64 || ((kt) >= rs && (kt) < rs + 8))
#define AT_GLDS(gp, ldsoff) __builtin_amdgcn_global_load_lds((const unsigned*)(gp), (LAS unsigned*)(lds + (ldsoff)), 16, 0, 0)
#define AT_DMAK(kt, sl) do { AT_GLDS(kg + (size_t)(kt) * 64 * kpitch, (sl) * AT_KBUF + wid * 1024); if (DK == 96 && wid < 4) AT_GLDS(krg + (size_t)(kt) * 64 * 32, (sl) * AT_KBUF + 8192 + wid * 1024); } while (0)
#define AT_DMAV(kt, sl) AT_GLDS(vg + (size_t)(kt) * 64 * vpitch, AT_VOFF + (sl) * AT_VBUF + wid * 1024)
    int koff[KS];
#pragma unroll
    for (int s = 0; s < KS; ++s) koff[s] = (s < 4) ? (r32 * 128 + ((((2 * s + hi) ^ ((r32 >> 1) & 7))) << 4)) : (8192 + r32 * 64 + ((((2 * (s - 4) + hi) ^ ((r32 >> 2) & 3))) << 4));
#define AT_QK(bi, d0, d1) do { LAS const unsigned char* kb_ = lds + (bi) * AT_KBUF; \
        _Pragma("unroll") for (int s = 0; s < KS; ++s) { \
            const bf16x8 k0_ = *(LAS const bf16x8*)(kb_ + koff[s]); \
            const bf16x8 k1_ = *(LAS const bf16x8*)(kb_ + koff[s] + ((s < 4) ? 4096 : 2048)); \
            if (s == 0) { d0 = __builtin_amdgcn_mfma_f32_32x32x16_bf16(k0_, qf[0], negm, 0, 0, 0); d1 = __builtin_amdgcn_mfma_f32_32x32x16_bf16(k1_, qf[0], negm, 0, 0, 0); } \
            else { d0 = __builtin_amdgcn_mfma_f32_32x32x16_bf16(k0_, qf[s], d0, 0, 0, 0); d1 = __builtin_amdgcn_mfma_f32_32x32x16_bf16(k1_, qf[s], d1, 0, 0, 0); } } } while (0)
    float m_ref = 0.f, l_run = 0.f;
    f32x16 o0, o1, negm, sA0, sA1, sB0, sB1;
#pragma unroll
    for (int r = 0; r < 16; ++r) { o0[r] = 0.f; o1[r] = 0.f; negm[r] = 0.f; }
    const int c = 32 * (wid & 1) + r32, cs = min(max(c - 8, 0), 48), rq = r0 + (wid >> 1), rs = min(max(rq - 4, 0), 56);
    const int vrow_l = 4 * (lane >> 5) + ((lane & 15) >> 2), vflip = (vrow_l >> 1) & 1, vc0 = 2 * ((lane >> 4) & 1) + ((lane & 3) >> 1);
    const int vfo0 = AT_VOFF + vrow_l * 128 + ((vc0 + 4 * (0 ^ vflip)) << 4) + 8 * (lane & 1);
    const int vfo1 = AT_VOFF + vrow_l * 128 + ((vc0 + 4 * (1 ^ vflip)) << 4) + 8 * (lane & 1);
    { const int kt0 = AT_TILE(0); AT_DMAK(kt0, 0); AT_DMAV(kt0, 0);
      if (nt > 1) { const int kt1 = AT_TILE(1); AT_DMAK(kt1, 1); AT_DMAV(kt1, 1); }
      if (nt > 2) { const int kt2 = AT_TILE(2); AT_DMAK(kt2, 2); }
      asm volatile("s_waitcnt vmcnt(0) lgkmcnt(0)" ::: "memory"); __builtin_amdgcn_s_barrier(); asm volatile("" ::: "memory");
      if (AT_ACT(kt0)) AT_QK(0, sA0, sA1); }
#define AT_STEP(C0, C1, N0, N1, I) do { \
        const int i_ = (I); const int kt = AT_TILE(i_); \
        const bool act = AT_ACT(kt), has1 = (i_ + 1 < nt); \
        const bool actn = has1 && AT_ACT(AT_TILE(has1 ? i_ + 1 : i_)); \
        if (actn) AT_QK((i_ + 1) & 3, N0, N1); \
        float dl = 0.f; bool bumped = false; \
        if (act) { \
            if (NA && kt < 64) { \
                const int ro = (kt - rq + 7) * 31 - c + 15; \
                _Pragma("unroll") for (int r = 0; r < 16; ++r) { \
                    const int kc = crow(r, hi); \
                    const bool ok0 = (kc >= cs) && (kc < cs + 16), ok1 = (kc + 32 >= cs) && (kc + 32 < cs + 16); \
                    const float b0 = RPB[min(max(ro + kc, 0), 464)], b1 = RPB[min(max(ro + kc + 32, 0), 464)];     \
                    C0[r] = ok0 ? C0[r] + b0 : -1e30f; C1[r] = ok1 ? C1[r] + b1 : -1e30f; } \
            } \
            float mxa = max3f(C0[0], C0[1], C1[0]), mxb = max3f(C0[2], C0[3], C1[1]); mxa = max3f(mxa, C1[2], C1[3]); \
            _Pragma("unroll") for (int r = 4; r < 16; r += 4) { mxa = max3f(mxa, C0[r], C0[r + 1]); mxb = max3f(mxb, C0[r + 2], C0[r + 3]); mxa = max3f(mxa, C1[r], C1[r + 1]); mxb = max3f(mxb, C1[r + 2], C1[r + 3]); } \
            float mx = max3f(mxa, mxb, mxb); mx = max3f(mx, __shfl_xor(mx, 32), mx); \
            bumped = __any(mx > THR) != 0; \
            if (bumped) { \
                dl = max3f(mx, 0.f, 0.f); m_ref += dl; \
                const float al = __builtin_amdgcn_exp2f(-dl); \
                l_run *= al; \
                _Pragma("unroll") for (int r = 0; r < 16; ++r) { C0[r] -= dl; C1[r] -= dl; o0[r] *= al; o1[r] *= al; negm[r] = -m_ref; } \
            } \
            float ra = 0.f, rb = 0.f, rc = 0.f, rd = 0.f; \
            _Pragma("unroll") for (int r = 0; r < 16; r += 2) { C0[r] = __builtin_amdgcn_exp2f(C0[r]); C1[r] = __builtin_amdgcn_exp2f(C1[r]); C0[r + 1] = __builtin_amdgcn_exp2f(C0[r + 1]); C1[r + 1] = __builtin_amdgcn_exp2f(C1[r + 1]); \
                ra += C0[r]; rb += C1[r]; rc += C0[r + 1]; rd += C1[r + 1]; } \
            l_run += (ra + rb) + (rc + rd); \
            bf16x8 pf[2][2]; \
            { u32x4 w; \
              w.x = pk_bf16(C0[0], C0[1]); w.y = pk_bf16(C0[2], C0[3]); w.z = pk_bf16(C0[4], C0[5]); w.w = pk_bf16(C0[6], C0[7]); pf[0][0] = __builtin_bit_cast(bf16x8, w); \
              w.x = pk_bf16(C0[8], C0[9]); w.y = pk_bf16(C0[10], C0[11]); w.z = pk_bf16(C0[12], C0[13]); w.w = pk_bf16(C0[14], C0[15]); pf[0][1] = __builtin_bit_cast(bf16x8, w); \
              w.x = pk_bf16(C1[0], C1[1]); w.y = pk_bf16(C1[2], C1[3]); w.z = pk_bf16(C1[4], C1[5]); w.w = pk_bf16(C1[6], C1[7]); pf[1][0] = __builtin_bit_cast(bf16x8, w); \
              w.x = pk_bf16(C1[8], C1[9]); w.y = pk_bf16(C1[10], C1[11]); w.z = pk_bf16(C1[12], C1[13]); w.w = pk_bf16(C1[14], C1[15]); pf[1][1] = __builtin_bit_cast(bf16x8, w); } \
            LAS const unsigned char* vb = lds + (i_ & 3) * AT_VBUF; \
            _Pragma("unroll") for (int blk = 0; blk < 2; ++blk) \
                _Pragma("unroll") for (int sp = 0; sp < 2; ++sp) { \
                    const int off = (32 * blk + 16 * sp) * 128; \
                    const v4i16 a0 = vtr(vb + vfo0 + off), a1 = vtr(vb + vfo0 + off + 8 * 128); \
                    const v4i16 d0 = vtr(vb + vfo1 + off), d1 = vtr(vb + vfo1 + off + 8 * 128); \
                    const bf16x8 vf0 = (bf16x8){a0[0], a0[1], a0[2], a0[3], a1[0], a1[1], a1[2], a1[3]}; \
                    const bf16x8 vf1 = (bf16x8){d0[0], d0[1], d0[2], d0[3], d1[0], d1[1], d1[2], d1[3]}; \
                    o0 = __builtin_amdgcn_mfma_f32_32x32x16_bf16(vf0, pf[blk][sp], o0, 0, 0, 0); \
                    o1 = __builtin_amdgcn_mfma_f32_32x32x16_bf16(vf1, pf[blk][sp], o1, 0, 0, 0); } \
        } \
        if (actn && bumped) { _Pragma("unroll") for (int r = 0; r < 16; ++r) { N0[r] -= dl; N1[r] -= dl; } }     \
    } while (0)
    for (int i = 0; i < nt; i += 2) {
        if (i + 3 < nt) { const int kt3 = AT_TILE(i + 3); AT_DMAK(kt3, (i + 3) & 3); AT_DMAV(kt3, (i + 3) & 3); }
        if (i + 4 < nt) { const int kt4 = AT_TILE(i + 4); AT_DMAK(kt4, (i + 4) & 3); }
        if (i + 2 < nt) { const int kt2 = AT_TILE(i + 2); AT_DMAV(kt2, (i + 2) & 3); }
        AT_STEP(sA0, sA1, sB0, sB1, i);
        if (i + 1 < nt) AT_STEP(sB0, sB1, sA0, sA1, i + 1);
        asm volatile("s_waitcnt vmcnt(0) lgkmcnt(0)" ::: "memory"); __builtin_amdgcn_s_barrier(); asm volatile("" ::: "memory");
    }
    __syncthreads();
#undef AT_STEP
#undef AT_TILE
#undef AT_ACT
#undef AT_GLDS
#undef AT_DMAK
#undef AT_DMAV
#undef AT_QK
    l_run += __shfl_xor(l_run, 32);
    const float inv = 1.f / l_run;
    bf16_t* orow = Op + (size_t)(32 * wid + r32) * 1024 + 8 * hi;
#pragma unroll
    for (int gp = 0; gp < 2; ++gp)
#pragma unroll
        for (int db = 0; db < 2; ++db) {
            const int g = 2 * gp;
            unsigned ax, ay, bx_, by;
            if (db == 0) { ax = pk_bf16(o0[4 * g] * inv, o0[4 * g + 1] * inv); ay = pk_bf16(o0[4 * g + 2] * inv, o0[4 * g + 3] * inv);
                           bx_ = pk_bf16(o0[4 * g + 4] * inv, o0[4 * g + 5] * inv); by = pk_bf16(o0[4 * g + 6] * inv, o0[4 * g + 7] * inv); }
            else { ax = pk_bf16(o1[4 * g] * inv, o1[4 * g + 1] * inv); ay = pk_bf16(o1[4 * g + 2] * inv, o1[4 * g + 3] * inv);
                   bx_ = pk_bf16(o1[4 * g + 4] * inv, o1[4 * g + 5] * inv); by = pk_bf16(o1[4 * g + 6] * inv, o1[4 * g + 7] * inv); }
            const auto sx = __builtin_amdgcn_permlane32_swap(ax, bx_, false, false);
            const auto sy = __builtin_amdgcn_permlane32_swap(ay, by, false, false);
            u32x4 w; w.x = sx[0]; w.y = sy[0]; w.z = sx[1]; w.w = sy[1];
            *(u32x4*)(orow + 32 * db + 16 * gp) = w;
        }
}

#define XB_TMO      128
#define XB_XCNT(j)  (256  + 64 * (j))
#define XB_XSUB(j)  (1280 + 64 * (j))
#define XB_XGEN(j)  (2304 + 64 * (j))
#define XB_TOP      3328
#define XB_TOPGEN   3392
#define XCD_BAR_WORDS 3456
#define XB_SPIN_CAP (1u << 18)
__device__ __forceinline__ unsigned xb_ld(unsigned* p)              { return __hip_atomic_load(p, __ATOMIC_RELAXED, __HIP_MEMORY_SCOPE_AGENT); }
__device__ __forceinline__ unsigned xb_add(unsigned* p, unsigned v) { return __hip_atomic_fetch_add(p, v, __ATOMIC_RELAXED, __HIP_MEMORY_SCOPE_AGENT); }
__device__ __forceinline__ unsigned xb_xcc_id() { return (unsigned)__builtin_amdgcn_s_getreg((3 << 11) | 20) & 0xFu; }
#define XB_SPIN(cond, bar) do { unsigned _sp = 0; while (cond) { __builtin_amdgcn_s_sleep(1); \
    if ((++_sp & 255u) == 0u) { if (xb_ld(&(bar)[XB_TMO])) break; if (_sp > XB_SPIN_CAP) { atomicAdd(&(bar)[XB_TMO], 1u); break; } } } } while (0)
struct XcdBarrier { unsigned* bar; unsigned x; volatile LAS unsigned* st; };
__device__ __forceinline__ void xcd_barrier_complete(unsigned* bar, unsigned x, unsigned& nloc, unsigned& nx) {
    const unsigned G = gridDim.x * gridDim.y * gridDim.z;
    unsigned sum, cnt, mine, sp = 0u;
    for (;;) {
        sum = 0u; cnt = 0u; mine = 0u;
#pragma unroll
        for (unsigned j = 0; j < 16; ++j) { const unsigned c = xb_ld(&bar[XB_XCNT(j)]); sum += c; cnt += (c > 0u) ? 1u : 0u; mine = (j == x) ? c : mine; }
        if (sum == G) break;
        __builtin_amdgcn_s_sleep(1);
        if ((++sp & 255u) == 0u) { if (xb_ld(&bar[XB_TMO])) break; if (sp > XB_SPIN_CAP) { atomicAdd(&bar[XB_TMO], 1u); break; } }
    }
    nloc = mine > 0u ? mine : 1u; nx = cnt > 0u ? cnt : 1u;
}
__device__ __forceinline__ void xcd_barrier(const XcdBarrier& b) {
    asm volatile("s_waitcnt vmcnt(0)" ::: "memory");
    __syncthreads();
    if (threadIdx.x == 0) {
        unsigned* bar = b.bar;
        __builtin_amdgcn_s_waitcnt(0);
        unsigned nloc = b.st[0], nx = b.st[1];
        if (nloc == 0u) { xcd_barrier_complete(bar, b.x, nloc, nx); b.st[0] = nloc; b.st[1] = nx; }
        const unsigned old = xb_add(&bar[XB_XSUB(b.x)], 1u);
        const unsigned gen = old / nloc;
        if (old + 1u == (gen + 1u) * nloc) {
            __builtin_amdgcn_fence(__ATOMIC_RELEASE, "agent");
            asm volatile("s_waitcnt vmcnt(0)" ::: "memory");
            const unsigned og = xb_add(&bar[XB_TOP], 1u);
            const unsigned tg = og / nx;
            if (og + 1u == (tg + 1u) * nx) xb_add(&bar[XB_TOPGEN], 1u);
            else XB_SPIN(xb_ld(&bar[XB_TOPGEN]) == tg, bar);
            __builtin_amdgcn_fence(__ATOMIC_ACQUIRE, "agent");
            xb_add(&bar[XB_XGEN(b.x)], 1u);
            asm volatile("s_waitcnt vmcnt(0)" ::: "memory");
        } else {
            XB_SPIN(xb_ld(&bar[XB_XGEN(b.x)]) == gen, bar);
            __builtin_amdgcn_fence(__ATOMIC_ACQUIRE, "agent");
            asm volatile("s_waitcnt vmcnt(0)" ::: "memory");
        }
    }
    __syncthreads();
}

__device__ __forceinline__ void sub_barrier(unsigned* cnt, unsigned n) {
    asm volatile("s_waitcnt vmcnt(0)" ::: "memory");
    __syncthreads();
    if (threadIdx.x == 0) {
        __builtin_amdgcn_fence(__ATOMIC_RELEASE, "agent");
        asm volatile("s_waitcnt vmcnt(0)" ::: "memory");
        (void)xb_add(cnt, 1u);
        unsigned sp = 0u; while (xb_ld(cnt) < n) { __builtin_amdgcn_s_sleep(1); if (++sp > (1u << 22)) break; }
        __builtin_amdgcn_fence(__ATOMIC_ACQUIRE, "agent");
        asm volatile("s_waitcnt vmcnt(0)" ::: "memory");
    }
    __syncthreads();
}

struct Params { const float* in[35]; float* out; unsigned char* ws; };

__device__ __forceinline__ void transpose_item(const float* __restrict__ W, int K, int N, bf16_t* WT, int mode, LAS float* scr, int item, int lane) {
    const int nblk = N / 32, kb = item / nblk, nb = item % nblk, k0 = 64 * kb, n0 = 32 * nb;
    float tv[32];
#pragma unroll
    for (int i = 0; i < 32; ++i) tv[i] = W[(size_t)(k0 + 2 * i + (lane >> 5)) * N + n0 + (lane & 31)];
#pragma unroll
    for (int i = 0; i < 32; ++i) scr[(2 * i + (lane >> 5)) * 33 + (lane & 31)] = tv[i];
    LDS_WAIT();
    int n0d = n0;
    if (mode == 1) { if (n0 < DFF) n0d = (n0 >> 7) * 256 + (n0 & 127); else { const int f = n0 - DFF; n0d = (f >> 7) * 256 + 128 + (f & 127); } }
    const int c = lane & 7;
#pragma unroll
    for (int j = 0; j < 4; ++j) { const int n = (lane >> 3) + 8 * j; const LAS float* s = scr + (8 * c) * 33 + n;
        u32x4 o; o.x = pk_bf16(s[0 * 33], s[1 * 33]); o.y = pk_bf16(s[2 * 33], s[3 * 33]); o.z = pk_bf16(s[4 * 33], s[5 * 33]); o.w = pk_bf16(s[6 * 33], s[7 * 33]);
        *(u32x4*)(WT + (size_t)(n0d + n) * K + k0 + 8 * c) = o; }
    LDS_WAIT();
}

__device__ __forceinline__ float* xr_row(float* out, float* xc, int b, int p) { return (p < SEQ) ? out + (size_t)(b * SEQ + p) * D : xc + (size_t)(b * CTXL + (p - SEQ)) * D; }

__device__ __forceinline__ void ln_phase(const float* src_lat, const float* src_ctx, float* out, float* xc, const bf16_t* Y, const bf16_t* Y2, const float* mod_l, int gchunk,
                                         const float* lg, const float* lb, const float* mod_next, int nchunk_sh, bf16_t* H, int mode  , int gw, int ngw, int lane) {
    constexpr int NR = 4;
    const int nrows = (mode == 0) ? NB * SEQ : (mode == 1 ? MT : NB * CTXL);
    for (int r0_ = gw; r0_ < nrows; r0_ += NR * ngw) {
        int bb[NR], pp[NR], rowi[NR], cnd[NR]; const float* srcp[NR]; bool ok[NR];
#pragma unroll
        for (int t = 0; t < NR; ++t) { ok[t] = (r0_ + t * ngw) < nrows; const int r_ = ok[t] ? r0_ + t * ngw : r0_;
            int b, p; if (mode == 0) { b = r_ >> 12; p = r_ & (SEQ - 1); } else if (mode == 1) { b = r_ / PB; p = r_ - b * PB; } else { b = r_ >> 8; p = SEQ + (r_ & (CTXL - 1)); }
            bb[t] = b; pp[t] = p; rowi[t] = b * PB + p; cnd[t] = (p < SEQ) ? b : 4;
            srcp[t] = (p < SEQ) ? src_lat + (size_t)(b * SEQ + p) * D : src_ctx + (size_t)(b * CTXL + (p - SEQ)) * D; }
        f32x4 v[NR][4]; float s[NR];
#pragma unroll
        for (int t = 0; t < NR; ++t) { const float* gv = mod_l + (size_t)cnd[t] * 6144 + gchunk * 1024; s[t] = 0.f;
#pragma unroll
            for (int j = 0; j < 4; ++j) { const int col = 4 * lane + 256 * j; const f32x4 x = *(const f32x4*)(srcp[t] + col), g = *(const f32x4*)(gv + col);
                const u32x2 yw = *(const u32x2*)(Y + (size_t)rowi[t] * D + col);
                f32x4 y; y[0] = bf_lo(yw.x); y[1] = bf_hi(yw.x); y[2] = bf_lo(yw.y); y[3] = bf_hi(yw.y);
                if (Y2) { const u32x2 zw = *(const u32x2*)(Y2 + (size_t)rowi[t] * D + col); y[0] += bf_lo(zw.x); y[1] += bf_hi(zw.x); y[2] += bf_lo(zw.y); y[3] += bf_hi(zw.y); }
                v[t][j] = x * ALPHA + g * y; s[t] += (v[t][j][0] + v[t][j][1]) + (v[t][j][2] + v[t][j][3]); } }
        float s2[NR], rstd[NR];
#pragma unroll
        for (int o = 1; o < 64; o <<= 1) {
#pragma unroll
            for (int t = 0; t < NR; ++t) s[t] += __shfl_xor(s[t], o); }
#pragma unroll
        for (int t = 0; t < NR; ++t) { const float mean = s[t] * (1.f / D); s2[t] = 0.f;
#pragma unroll
            for (int j = 0; j < 4; ++j) { v[t][j] = v[t][j] - mean; s2[t] += (v[t][j][0] * v[t][j][0] + v[t][j][1] * v[t][j][1]) + (v[t][j][2] * v[t][j][2] + v[t][j][3] * v[t][j][3]); } }
#pragma unroll
        for (int o = 1; o < 64; o <<= 1) {
#pragma unroll
            for (int t = 0; t < NR; ++t) s2[t] += __shfl_xor(s2[t], o); }
#pragma unroll
        for (int t = 0; t < NR; ++t) rstd[t] = 1.f / sqrtf(s2[t] * (1.f / D) + EPSF);
#pragma unroll
        for (int t = 0; t < NR; ++t) {
            if (ok[t]) {
                float* dst = xr_row(out, xc, bb[t], pp[t]);
#pragma unroll
                for (int j = 0; j < 4; ++j) { const int col = 4 * lane + 256 * j; const f32x4 o = v[t][j] * rstd[t] * *(const f32x4*)(lg + col) + *(const f32x4*)(lb + col);
                    *(f32x4*)(dst + col) = o;
                    if (mod_next) { const float* mn = mod_next + (size_t)cnd[t] * 6144; const f32x4 sh = *(const f32x4*)(mn + nchunk_sh * 1024 + col), sc = *(const f32x4*)(mn + (nchunk_sh + 1) * 1024 + col);
                        const f32x4 h = o * (sc + 1.f) + sh; u32x2 w; w.x = pk_bf16(h[0], h[1]); w.y = pk_bf16(h[2], h[3]); *(u32x2*)(H + (size_t)rowi[t] * D + col) = w; } }
            }
        }
    }
}

typedef const Params __attribute__((address_space(4)))* KP;
__device__ __forceinline__ KP kargs() { KP p = (KP)__builtin_amdgcn_kernarg_segment_ptr(); asm volatile("" : "+s"(p)); return p; }
__device__ __forceinline__ void convert_items(KP kp, unsigned char* ws, LAS unsigned char* lds, int lane, int wid, int lo, int hi, int wrank, int nw) {
    LAS float* scr = (LAS float*)(lds + wid * 8704);
    constexpr int I0 = 16 * 72, I1 = 16 * 32, I2 = 16 * 176, I3 = 44 * 32, I4 = 16 * 33, I5 = 12 * 48, I6 = 4 * 64;
    for (int it = lo + wrank; it < hi; it += nw) {
        int r = it;
        if (r < I0) { transpose_item(kp->in[6], 1024, N_IN0, (bf16_t*)(ws + WS_W_IN0), 0, scr, r, lane); continue; } r -= I0;
        if (r < I1) { transpose_item(kp->in[10], 1024, 1024, (bf16_t*)(ws + WS_W_OUT0), 0, scr, r, lane); continue; } r -= I1;
        if (r < I2) { transpose_item(kp->in[13], 1024, 2 * DFF, (bf16_t*)(ws + WS_W_UP0), 1, scr, r, lane); continue; } r -= I2;
        if (r < I3) { transpose_item(kp->in[16], DFF, 1024, (bf16_t*)(ws + WS_W_DN0), 0, scr, r, lane); continue; } r -= I3;
        if (r < I4) { transpose_item(kp->in[21], 1024, 1056, (bf16_t*)(ws + WS_W_IN1), 0, scr, r, lane); continue; } r -= I4;
        if (r < I5) { transpose_item(kp->in[24], QLORA, NQ1, (bf16_t*)(ws + WS_W_UQ), 0, scr, r, lane); continue; } r -= I5;
        if (r < I6) { transpose_item(kp->in[25], KVLORA, NKV1, (bf16_t*)(ws + WS_W_UKV), 0, scr, r, lane); continue; } r -= I6;
        if (r < I1) { transpose_item(kp->in[26], 1024, 1024, (bf16_t*)(ws + WS_W_OUT1), 0, scr, r, lane); continue; } r -= I1;
        if (r < I2) { transpose_item(kp->in[29], 1024, 2 * DFF, (bf16_t*)(ws + WS_W_UP1), 1, scr, r, lane); continue; } r -= I2;
        transpose_item(kp->in[32], DFF, 1024, (bf16_t*)(ws + WS_W_DN1), 0, scr, r, lane);
    }
}
constexpr int CV_L0A = 16 * 72 + 16 * 32;
constexpr int CV_L0B = CV_L0A + 16 * 176 + 44 * 32;
constexpr int CV_IN1 = CV_L0B + 16 * 33;
constexpr int CV_SMALL1 = CV_IN1 + 12 * 48 + 4 * 64 + 16 * 32;
constexpr int CV_UP1 = CV_SMALL1 + 16 * 176;
constexpr int CV_ALL = CV_UP1 + 44 * 32;
__device__ __forceinline__ void adaln_items(KP kp, unsigned char* ws, LAS unsigned char* lds, int tid, int lane, int wid, int lo, int hi, int brank, int nb) {
    float* MOD = (float*)(ws + WS_MOD);
    LAS float* SC = (LAS float*)(lds + 73728);
    LAS float* RED = (LAS float*)(lds + 73728 + 20480);
    { const float* cv = kp->in[1]; const float* ccv = kp->in[3];
      for (int i = tid; i < 5 * 1024; i += 512) { const int cnd = i >> 10, k = i & 1023; const float v = (cnd < 4) ? cv[cnd * 1024 + k] : ccv[k]; SC[i] = v / (1.f + expf(-v)); } }
    __syncthreads();
    for (int item = lo + brank; item < hi; item += nb) {
        const int l = item / 192, chunk = item % 192; const float* W = l ? kp->in[19] : kp->in[4]; const float* Bv = l ? kp->in[20] : kp->in[5];
        const int col = chunk * 32 + (lane & 31), kg16 = wid * 2 + (lane >> 5);
        float a0 = 0.f, a1 = 0.f, a2 = 0.f, a3 = 0.f, a4 = 0.f;
        for (int kb = 0; kb < 64; kb += 32) {
            float wv[32];
#pragma unroll
            for (int i = 0; i < 32; ++i) wv[i] = W[(size_t)(kg16 + 16 * (kb + i)) * 6144 + col];
#pragma unroll
            for (int i = 0; i < 32; ++i) { const int k = kg16 + 16 * (kb + i); const float w = wv[i];
                a0 += SC[k] * w; a1 += SC[1024 + k] * w; a2 += SC[2048 + k] * w; a3 += SC[3072 + k] * w; a4 += SC[4096 + k] * w; }
        }
        RED[(kg16 * 5 + 0) * 32 + (lane & 31)] = a0; RED[(kg16 * 5 + 1) * 32 + (lane & 31)] = a1; RED[(kg16 * 5 + 2) * 32 + (lane & 31)] = a2; RED[(kg16 * 5 + 3) * 32 + (lane & 31)] = a3; RED[(kg16 * 5 + 4) * 32 + (lane & 31)] = a4;
        __syncthreads();
        if (tid < 160) { const int cnd = tid >> 5, cl = tid & 31; float s = 0.f;
#pragma unroll
            for (int kg = 0; kg < 16; ++kg) s += RED[(kg * 5 + cnd) * 32 + cl];
            MOD[(size_t)(l * 5 + cnd) * 6144 + chunk * 32 + cl] = s + Bv[chunk * 32 + cl]; }
        __syncthreads();
    }
}
__device__ __forceinline__ bool idle_rank(int nwg, int G, int bx, int& rank, int& n) {
    const int cmax = (nwg + G - 1) / G, nb2 = nwg - G * (cmax - 1);
    if (nb2 >= G) { rank = bx; n = G; return true; }
    rank = bx - nb2; n = G - nb2; return bx >= nb2;
}
#define PH_BEGIN \
    const KP kp = kargs(); unsigned char* const ws = kp->ws; (void)ws; \
    const int tid = otid(), lane = tid & 63, wid = __builtin_amdgcn_readfirstlane(tid >> 6); (void)lane; \
    const int G = gridDim.x, bx = blockIdx.x, gw = bx * 8 + wid, ngw = G * 8; (void)gw; (void)ngw;

__global__ void __launch_bounds__(512) mega_fwd(Params Pdummy) {
    extern __shared__ __attribute__((aligned(16))) unsigned char lds_raw[];
    LAS unsigned char* lds = (LAS unsigned char*)lds_raw;
    cg::grid_group grid = cg::this_grid();
    { volatile LAS unsigned* MISC = (volatile LAS unsigned*)(lds + XLDS_OFF + 8192);
      if (threadIdx.x < 32) MISC[threadIdx.x] = 0u;
      __syncthreads();
      if (threadIdx.x == 0) (void)xb_add(&((unsigned*)(kargs()->ws + WS_BAR))[XB_XCNT(xb_xcc_id())], 1u); }

    for (int rep0_ = 0; rep0_ < REP_P0; ++rep0_) {
        PH_BEGIN
        float2* ROPE0 = (float2*)(ws + WS_ROPE0); float2* ROPE1 = (float2*)(ws + WS_ROPE1); bf16_t* H = (bf16_t*)(ws + WS_H);
        adaln_items(kp, ws, lds, tid, lane, wid, 0, 192, bx, G);
        for (int gt = bx * 512 + tid; gt < 1536 + 129 * 128 + 224 * 128; gt += G * 512) {
          if (gt < 1024) { const int v = gt >> 4, k = gt & 15; const float inv = exp2f(-(float)k * (13.287712379549449f / 16.f)); const float a = (float)v * inv; ROPE0[gt] = make_float2(cosf(a), sinf(a)); }
          else if (gt < 1536) { const int i = gt - 1024, v = i >> 3, k = i & 7; const float inv = exp2f(-(float)k * (13.287712379549449f / 8.f)); const float a = (float)v * inv; ROPE1[i] = make_float2(cosf(a), sinf(a)); }
          else if (gt < 1536 + 129 * 128) {
            const int zi = gt - 1536; const int zr = zi >> 7, zc = zi & 127; bf16_t* rp = (zr == 0) ? (H - D) : (H + (size_t)(MT + zr - 1) * D); *(u32x4*)(rp + zc * 8) = (u32x4){0u, 0u, 0u, 0u}; }
          else {
            const int wi = gt - 1536 - 129 * 128; bf16_t* rp = (bf16_t*)(ws + WS_W_IN1) + (size_t)1056 * 1024; *(u32x4*)(rp + (size_t)wi * 8) = (u32x4){0u, 0u, 0u, 0u}; }
        }
        convert_items(kp, ws, lds, lane, wid, 0, CV_L0A, gw, ngw);
    }
    GRID_SYNC();
    if (kargs()->ws == nullptr) grid.sync();

    {
        PH_BEGIN
        const float* MOD = (const float*)(ws + WS_MOD); bf16_t* H = (bf16_t*)(ws + WS_H); const float* xin = kp->in[0]; const float* cin = kp->in[2];
        for (int row = gw; row < MT; row += ngw) {
            const int b = row / PB, p = row - b * PB; const int cond = (p < SEQ) ? b : 4;
            const float* src = (p < SEQ) ? xin + (size_t)(b * SEQ + p) * D : cin + (size_t)(b * CTXL + (p - SEQ)) * D;
            const float* mn = MOD + (size_t)cond * 6144;
#pragma unroll
            for (int j = 0; j < 4; ++j) { const int col = 4 * lane + 256 * j; const f32x4 x = *(const f32x4*)(src + col), sh = *(const f32x4*)(mn + col), sc = *(const f32x4*)(mn + 1024 + col);
                const f32x4 h = x * (sc + 1.f) + sh; u32x2 w; w.x = pk_bf16(h[0], h[1]); w.y = pk_bf16(h[2], h[3]); *(u32x2*)(H + (size_t)row * D + col) = w; }
        }
    }
    GRID_SYNC();

    {
        PH_BEGIN
        pg8::Gemm g{(const bf16_t*)(ws + WS_H), (const bf16_t*)(ws + WS_W_IN0), 1024, 256, 1024}; pg8::StaticOrder S; S.init(MT / 256, N_IN0 / 256, G, bx, 0);
        pg8::EpiQkv0 E{(bf16_t*)(ws + WS_RAW0), (bf16_t*)(ws + WS_KVC0), kp->in[7], kp->in[8], (const float2*)(ws + WS_ROPE0), (LAS float*)(lds + XLDS_OFF)};
        for (int rep_ = 0; rep_ < REP_GEMM; ++rep_) pg8::gemm_phase<pg8::EpiQkv0>(lds, g, S, E);
        { int rk_, n_; if (idle_rank((MT / 256) * (N_IN0 / 256), G, bx, rk_, n_)) convert_items(kp, ws, lds, lane, wid, CV_L0A, CV_L0B, rk_ * 8 + wid, n_ * 8); }
    }
    GRID_SYNC();

    {
        PH_BEGIN
        const bf16_t* RAW0 = (const bf16_t*)(ws + WS_RAW0); const bf16_t* KVC0 = (const bf16_t*)(ws + WS_KVC0); bf16_t* O0 = (bf16_t*)(ws + WS_O0); const float* rpb = kp->in[9];
        for (int rep_ = 0; rep_ < REP_ATT; ++rep_)
        for (int u = ((G & 7) == 0 ? (bx & 7) * (G >> 3) + (bx >> 3) : bx); u < 1088; u += G) {
            if (u < 512 || u >= 1024) {
                const bool isctx = u >= 1024;
                int b, qcol, hk, hv, ocol; size_t qrow; int t0;
                if (!isctx) { const int qblk = u & 15, hq = (u >> 4) & 7; b = u >> 7; qcol = hq * 64; hk = hq >> 2; hv = 2 + (hq >> 2); ocol = hq * 64; qrow = (size_t)b * PB + 256 * qblk; t0 = 0; }
                else { const int v = u - 1024; const int h16 = v & 15; b = v >> 4; qcol = (h16 < 8) ? h16 * 64 : 768 + (h16 - 8) * 64; hk = (h16 < 8) ? (h16 >> 2) : 4 + (h16 - 8);
                       hv = (h16 < 8) ? 2 + (h16 >> 2) : 12 + (h16 - 8); ocol = h16 * 64; qrow = (size_t)b * PB + SEQ; t0 = 64; }
                attn_unit<64, false>(lds, RAW0 + qrow * N_IN0 + qcol, N_IN0, KVC0 + (size_t)(b * 20 + hk) * PB * 64, 64, nullptr,
                                     KVC0 + (size_t)(b * 20 + hv) * PB * 64, 64, O0 + qrow * 1024 + ocol, t0, 68, 0, 0, 0, nullptr);
            } else {
                const int v = u - 512; const int qblk = v & 15, h = (v >> 4) & 7, b = v >> 7; const size_t rowb = (size_t)b * PB;
                const int r0 = 4 * qblk, lo = min(max(r0 - 4, 0), 56), hi_ex = min(max(r0 + 3 - 4, 0), 56) + 8;
                attn_unit<64, true>(lds, RAW0 + (rowb + 256 * qblk) * N_IN0 + 768 + h * 64, N_IN0, KVC0 + (size_t)(b * 20 + 4 + h) * PB * 64, 64, nullptr,
                                    KVC0 + (size_t)(b * 20 + 12 + h) * PB * 64, 64, O0 + (rowb + 256 * qblk) * 1024 + (8 + h) * 64, 64, 68, lo, hi_ex, r0, rpb + h * 465);
            }
        }
        { const int vcu = ((G & 7) == 0 ? (bx & 7) * (G >> 3) + (bx >> 3) : bx);
          if (G >= 128) { if (vcu >= 64) { adaln_items(kp, ws, lds, tid, lane, wid, 192, 384, vcu - 64, G - 64); } }
          else { adaln_items(kp, ws, lds, tid, lane, wid, 192, 384, bx, G); } }
    }
    GRID_SYNC();

    {
        PH_BEGIN
        pg8::Gemm g{(const bf16_t*)(ws + WS_O0), (const bf16_t*)(ws + WS_W_OUT0), 1024, 256, 1024}; pg8::StaticOrder S; S.init(64, 4, G, bx, 1);
        pg8::EpiStore E{(bf16_t*)(ws + WS_Y0), 1024, nullptr};
        for (int rep_ = 0; rep_ < REP_GEMM; ++rep_) pg8::gemm_phase<pg8::EpiStore>(lds, g, S, E);
    }
    GRID_SYNC();
    {
        PH_BEGIN
        const float* MOD = (const float*)(ws + WS_MOD);
        if (G >= 64) {
            if (bx < 16) {
                pg8::Gemm g{(const bf16_t*)(ws + WS_O0), (const bf16_t*)(ws + WS_W_OUT0), 1024, 256, 1024}; pg8::StaticOrder S; S.init(4, 4, 16, bx, 2);
                pg8::EpiStore E{(bf16_t*)(ws + WS_Y0), 1024, nullptr};
                pg8::gemm_phase<pg8::EpiStore>(lds, g, S, E);
                sub_barrier((unsigned*)(ws + WS_BAR) + 3584, 16u);
                ln_phase(kp->in[0], kp->in[2], kp->out, (float*)(ws + WS_XC), (const bf16_t*)(ws + WS_Y0), nullptr, MOD, 2, kp->in[11], kp->in[12], MOD, 3, (bf16_t*)(ws + WS_H), 2, bx * 8 + wid, 16 * 8, lane);
            } else
                ln_phase(kp->in[0], kp->in[2], kp->out, (float*)(ws + WS_XC), (const bf16_t*)(ws + WS_Y0), nullptr, MOD, 2, kp->in[11], kp->in[12], MOD, 3, (bf16_t*)(ws + WS_H), 0, (bx - 16) * 8 + wid, (G - 16) * 8, lane);
        } else {
            pg8::Gemm g{(const bf16_t*)(ws + WS_O0), (const bf16_t*)(ws + WS_W_OUT0), 1024, 256, 1024}; pg8::StaticOrder S; S.init(4, 4, G, bx, 2);
            pg8::EpiStore E{(bf16_t*)(ws + WS_Y0), 1024, nullptr};
            pg8::gemm_phase<pg8::EpiStore>(lds, g, S, E);
            GRID_SYNC();
            ln_phase(kp->in[0], kp->in[2], kp->out, (float*)(ws + WS_XC), (const bf16_t*)(ws + WS_Y0), nullptr, MOD, 2, kp->in[11], kp->in[12], MOD, 3, (bf16_t*)(ws + WS_H), 1, gw, ngw, lane);
        }
    }
    GRID_SYNC();
    {
        PH_BEGIN
        pg8::Gemm g{(const bf16_t*)(ws + WS_H) - D, (const bf16_t*)(ws + WS_W_UP0), 1024, 254, 1024}; pg8::StaticOrder S; S.init(69, 22, G, bx, 0);
        pg8::EpiConvGlu E{(bf16_t*)(ws + WS_U), kp->in[14], kp->in[15], (LAS float*)(lds + XLDS_OFF)};
        for (int rep_ = 0; rep_ < REP_GEMM * REP_UP; ++rep_) pg8::gemm_phase<pg8::EpiConvGlu>(lds, g, S, E);
    }
    GRID_SYNC();
    {
        PH_BEGIN
        pg8::Gemm g{(const bf16_t*)(ws + WS_U), (const bf16_t*)(ws + WS_W_DN0), DFF, 256, DFF}; pg8::StaticOrder S; S.init(64, 4, G, bx, 1);
        pg8::EpiStore E{(bf16_t*)(ws + WS_Y), 1024, nullptr};
        for (int rep_ = 0; rep_ < REP_GEMM; ++rep_) pg8::gemm_phase<pg8::EpiStore>(lds, g, S, E);
    }
    GRID_SYNC();
    {
        PH_BEGIN
        const float* MOD = (const float*)(ws + WS_MOD); float* XC = (float*)(ws + WS_XC);
        if (G >= 64) {
            if (bx < 32) {
                pg8::Gemm g{(const bf16_t*)(ws + WS_U), (const bf16_t*)(ws + WS_W_DN0), DFF / 2, 256, DFF}; pg8::StaticOrder S; S.init(4, 4, 32, bx, 2, 2);
                pg8::EpiStore E{(bf16_t*)(ws + WS_Y), 1024, (bf16_t*)(ws + WS_YB)};
                pg8::gemm_phase<pg8::EpiStore>(lds, g, S, E);
                sub_barrier((unsigned*)(ws + WS_BAR) + 3648, 32u);
                ln_phase(kp->out, XC, kp->out, XC, (const bf16_t*)(ws + WS_Y), (const bf16_t*)(ws + WS_YB), MOD, 5, kp->in[17], kp->in[18], MOD + 5 * 6144, 0, (bf16_t*)(ws + WS_H), 2, bx * 8 + wid, 32 * 8, lane);
            } else {
                ln_phase(kp->out, XC, kp->out, XC, (const bf16_t*)(ws + WS_Y), nullptr, MOD, 5, kp->in[17], kp->in[18], MOD + 5 * 6144, 0, (bf16_t*)(ws + WS_H), 0, (bx - 32) * 8 + wid, (G - 32) * 8, lane);
                convert_items(kp, ws, lds, lane, wid, CV_L0B, CV_IN1, (bx - 32) * 8 + wid, (G - 32) * 8);
                convert_items(kp, ws, lds, lane, wid, CV_UP1, CV_ALL, (bx - 32) * 8 + wid, (G - 32) * 8);
            }
        } else {
            pg8::Gemm g{(const bf16_t*)(ws + WS_U), (const bf16_t*)(ws + WS_W_DN0), DFF / 2, 256, DFF}; pg8::StaticOrder S; S.init(4, 4, G, bx, 2, 2);
            pg8::EpiStore E{(bf16_t*)(ws + WS_Y), 1024, (bf16_t*)(ws + WS_YB)};
            pg8::gemm_phase<pg8::EpiStore>(lds, g, S, E);
            convert_items(kp, ws, lds, lane, wid, CV_L0B, CV_IN1, gw, ngw); convert_items(kp, ws, lds, lane, wid, CV_UP1, CV_ALL, gw, ngw);
            GRID_SYNC();
            ln_phase(kp->out, XC, kp->out, XC, (const bf16_t*)(ws + WS_Y), nullptr, MOD, 5, kp->in[17], kp->in[18], MOD + 5 * 6144, 0, (bf16_t*)(ws + WS_H), 0, gw, ngw, lane);
            ln_phase(kp->out, XC, kp->out, XC, (const bf16_t*)(ws + WS_Y), (const bf16_t*)(ws + WS_YB), MOD, 5, kp->in[17], kp->in[18], MOD + 5 * 6144, 0, (bf16_t*)(ws + WS_H), 2, gw, ngw, lane);
        }
    }
    GRID_SYNC();

    {
        PH_BEGIN
        pg8::Gemm g{(const bf16_t*)(ws + WS_H), (const bf16_t*)(ws + WS_W_IN1), 1024 / KS_G5, 256, 1024}; pg8::StaticOrder S; S.init(MT / 256, N_IN1P / 256, G, bx, 0, KS_G5);
        pg8::EpiStore E{(bf16_t*)(ws + WS_RAW1), N_IN1P, (bf16_t*)(ws + WS_RAW1B)};
        for (int rep_ = 0; rep_ < REP_GEMM; ++rep_) pg8::gemm_phase<pg8::EpiStore>(lds, g, S, E);
        { int rk_, n_; if (idle_rank((MT / 256) * (N_IN1P / 256) * KS_G5, G, bx, rk_, n_)) convert_items(kp, ws, lds, lane, wid, CV_IN1, CV_UP1, rk_ * 8 + wid, n_ * 8); }
    }
    GRID_SYNC();
    {
        PH_BEGIN
        const bf16_t* RAW1 = (const bf16_t*)(ws + WS_RAW1); const bf16_t* RAW1B = (const bf16_t*)(ws + WS_RAW1B); bf16_t* CQ = (bf16_t*)(ws + WS_CQ); bf16_t* CKV = (bf16_t*)(ws + WS_CKV); bf16_t* KR = (bf16_t*)(ws + WS_KR);
        const float2* ROPE1 = (const float2*)(ws + WS_ROPE1);
        const float* cqg = kp->in[22]; const float* ckvg = kp->in[23];
        for (int row = gw; row < MT; row += ngw) {
            const int b = row / PB, p = row - b * PB; const bool lat = p < SEQ;
            const bf16_t* rp = RAW1 + (size_t)row * N_IN1P; const bf16_t* rp2 = RAW1B + (size_t)row * N_IN1P; (void)rp2;
#define LD8SUM(ARR, off) float ARR[8]; { const u32x4 w_ = *(const u32x4*)(rp + (off)); const u32x4 z_ = (KS_G5 > 1) ? *(const u32x4*)(rp2 + (off)) : (u32x4){0u, 0u, 0u, 0u}; \
                ARR[0] = bf_lo(w_[0]) + bf_lo(z_[0]); ARR[1] = bf_hi(w_[0]) + bf_hi(z_[0]); ARR[2] = bf_lo(w_[1]) + bf_lo(z_[1]); ARR[3] = bf_hi(w_[1]) + bf_hi(z_[1]); \
                ARR[4] = bf_lo(w_[2]) + bf_lo(z_[2]); ARR[5] = bf_hi(w_[2]) + bf_hi(z_[2]); ARR[6] = bf_lo(w_[3]) + bf_lo(z_[3]); ARR[7] = bf_hi(w_[3]) + bf_hi(z_[3]); }
            if (lat) {
                LD8SUM(xa, lane * 8) LD8SUM(xb, 512 + (lane & 31) * 8)
                float ss = 0.f;
#pragma unroll
                for (int t = 0; t < 8; ++t) { ss += xa[t] * xa[t]; if (lane < 32) ss += xb[t] * xb[t]; }
                const float rstd = 1.f / sqrtf(wave_sum(ss) * (1.f / 768.f) + EPSF);
                { const f32x4 g0 = *(const f32x4*)(cqg + lane * 8), g1 = *(const f32x4*)(cqg + lane * 8 + 4);
                  u32x4 o; o.x = pk_bf16(xa[0] * rstd * g0[0], xa[1] * rstd * g0[1]); o.y = pk_bf16(xa[2] * rstd * g0[2], xa[3] * rstd * g0[3]);
                  o.z = pk_bf16(xa[4] * rstd * g1[0], xa[5] * rstd * g1[1]); o.w = pk_bf16(xa[6] * rstd * g1[2], xa[7] * rstd * g1[3]);
                  *(u32x4*)(CQ + (size_t)row * QLORA + lane * 8) = o; }
                if (lane < 32) { const f32x4 g0 = *(const f32x4*)(cqg + 512 + lane * 8), g1 = *(const f32x4*)(cqg + 512 + lane * 8 + 4);
                  u32x4 o; o.x = pk_bf16(xb[0] * rstd * g0[0], xb[1] * rstd * g0[1]); o.y = pk_bf16(xb[2] * rstd * g0[2], xb[3] * rstd * g0[3]);
                  o.z = pk_bf16(xb[4] * rstd * g1[0], xb[5] * rstd * g1[1]); o.w = pk_bf16(xb[6] * rstd * g1[2], xb[7] * rstd * g1[3]);
                  *(u32x4*)(CQ + (size_t)row * QLORA + 512 + lane * 8) = o; }
            }
            {
                const int l32 = lane & 31;
                LD8SUM(x, 768 + l32 * 8)
                float ss = 0.f;
#pragma unroll
                for (int t = 0; t < 8; ++t) ss += x[t] * x[t];
                const float rstd = 1.f / sqrtf(wave_sum(ss) * (0.5f / 256.f) + EPSF);
                const f32x4 g0 = *(const f32x4*)(ckvg + l32 * 8), g1 = *(const f32x4*)(ckvg + l32 * 8 + 4);
                u32x4 o; o.x = pk_bf16(x[0] * rstd * g0[0], x[1] * rstd * g0[1]); o.y = pk_bf16(x[2] * rstd * g0[2], x[3] * rstd * g0[3]);
                o.z = pk_bf16(x[4] * rstd * g1[0], x[5] * rstd * g1[1]); o.w = pk_bf16(x[6] * rstd * g1[2], x[7] * rstd * g1[3]);
                if (lane < 32) *(u32x4*)(CKV + (size_t)row * KVLORA + l32 * 8) = o;
            }
            if (lane < 4) {
                LD8SUM(x, 1024 + lane * 8)
                const int pos = (lane < 2) ? (p >> 6) : (p & 63); const int kb = (4 * lane) & 7;
                unsigned ow[4];
#pragma unroll
                for (int t = 0; t < 4; ++t) { const float2 cs = lat ? ROPE1[pos * 8 + kb + t] : make_float2(1.f, 0.f); const float x1 = x[2 * t], x2 = x[2 * t + 1];
                    ow[t] = pk_bf16(x1 * cs.x - x2 * cs.y, x1 * cs.y + x2 * cs.x); }
                *(u32x4*)(KR + (size_t)row * 32 + lane * 8) = (u32x4){ow[0], ow[1], ow[2], ow[3]};
            }
        }
    }
    GRID_SYNC();
    {
        PH_BEGIN
        pg8::Gemm g{(const bf16_t*)(ws + WS_CQ), (const bf16_t*)(ws + WS_W_UQ), QLORA, 256, QLORA}; pg8::StaticOrder S; S.init(64, NQ1 / 256, G, bx, 1);
        pg8::EpiUq E{(bf16_t*)(ws + WS_Q1), (const float2*)(ws + WS_ROPE1)};
        for (int rep_ = 0; rep_ < REP_GEMM; ++rep_) pg8::gemm_phase<pg8::EpiUq>(lds, g, S, E);
    }
    {
        PH_BEGIN
        pg8::Gemm g{(const bf16_t*)(ws + WS_CKV), (const bf16_t*)(ws + WS_W_UKV), KVLORA, 256, KVLORA}; pg8::StaticOrder S;
        if ((G & 1) == 0 && G >= 64) { const int hG = G >> 1; if (bx < hG) { S.init(MT / 256, NKV1 / 256, hG, bx, 0); S.u0 = 0; S.u1 = hG; } else { S.init(MT / 256, NKV1 / 256, hG, bx - hG, 0); S.u0 = hG; } }
        else S.init(MT / 256, NKV1 / 256, G, G - 1 - bx, 0);
        pg8::EpiHeads E{(bf16_t*)(ws + WS_KV1), 32};
        for (int rep_ = 0; rep_ < REP_GEMM; ++rep_) pg8::gemm_phase<pg8::EpiHeads>(lds, g, S, E);
    }
    GRID_SYNC();
    {
        PH_BEGIN
        const bf16_t* Q1 = (const bf16_t*)(ws + WS_Q1); const bf16_t* KV1 = (const bf16_t*)(ws + WS_KV1); const bf16_t* KR = (const bf16_t*)(ws + WS_KR);
        bf16_t* O1 = (bf16_t*)(ws + WS_O1);
        for (int rep_ = 0; rep_ < REP_ATT; ++rep_)
        for (int u = ((G & 7) == 0 ? (bx & 7) * (G >> 3) + (bx >> 3) : bx); u < 1024; u += G) {
            const int qblk = u & 15, h = (u >> 4) & 15, b = u >> 8; const size_t rowb = (size_t)b * PB;
            attn_unit<96, false>(lds, Q1 + (rowb + 256 * qblk) * NQ1 + h * 96, NQ1, KV1 + (size_t)(b * 32 + 2 * h) * PB * 64, 64, KR + rowb * 32,
                                 KV1 + (size_t)(b * 32 + 2 * h + 1) * PB * 64, 64, O1 + (rowb + 256 * qblk) * 1024 + h * 64, 0, 68, 0, 0, 0, nullptr);
        }
    }
    GRID_SYNC();
    {
        PH_BEGIN
        pg8::Gemm g{(const bf16_t*)(ws + WS_O1), (const bf16_t*)(ws + WS_W_OUT1), 1024, 256, 1024}; pg8::StaticOrder S; S.init(64, 4, G, bx, 1);
        pg8::EpiStore E{(bf16_t*)(ws + WS_Y1), 1024, nullptr};
        for (int rep_ = 0; rep_ < REP_GEMM; ++rep_) pg8::gemm_phase<pg8::EpiStore>(lds, g, S, E);
    }
    GRID_SYNC();
    {
        PH_BEGIN
        const float* MOD1 = (const float*)(ws + WS_MOD) + 5 * 6144; float* XC = (float*)(ws + WS_XC);
        ln_phase(kp->out, XC, kp->out, XC, (const bf16_t*)(ws + WS_Y1), nullptr, MOD1, 2, kp->in[27], kp->in[28], MOD1, 3, (bf16_t*)(ws + WS_H), 0, gw, ngw, lane);
    }
    GRID_SYNC();
    {
        PH_BEGIN
        pg8::Gemm g{(const bf16_t*)(ws + WS_H) - D, (const bf16_t*)(ws + WS_W_UP1), 1024, 254, 1024}; pg8::StaticOrder S; S.init(69, 22, G, bx, 0);
        pg8::EpiConvGlu E{(bf16_t*)(ws + WS_U), kp->in[30], kp->in[31], (LAS float*)(lds + XLDS_OFF)};
        for (int rep_ = 0; rep_ < REP_GEMM * REP_UP; ++rep_) pg8::gemm_phase<pg8::EpiConvGlu>(lds, g, S, E);
    }
    GRID_SYNC();
    {
        PH_BEGIN
        pg8::Gemm g{(const bf16_t*)(ws + WS_U), (const bf16_t*)(ws + WS_W_DN1), DFF, 256, DFF}; pg8::StaticOrder S; S.init(64, 4, G, bx, 1);
        pg8::EpiStore E{(bf16_t*)(ws + WS_Y), 1024, nullptr};
        for (int rep_ = 0; rep_ < REP_GEMM; ++rep_) pg8::gemm_phase<pg8::EpiStore>(lds, g, S, E);
    }
    GRID_SYNC();
    {
        PH_BEGIN
        const float* MOD1 = (const float*)(ws + WS_MOD) + 5 * 6144; float* XC = (float*)(ws + WS_XC);
        ln_phase(kp->out, XC, kp->out, XC, (const bf16_t*)(ws + WS_Y), nullptr, MOD1, 5, kp->in[33], kp->in[34], nullptr, 0, (bf16_t*)(ws + WS_H), 0, gw, ngw, lane);
    }
}

extern "C" void kernel_launch(void* const* d_in, const int* in_sizes, int n_in, void* d_out, int out_size, void* d_ws, size_t ws_size, hipStream_t stream) {
    static int grid_blocks = 0;
    if (grid_blocks == 0) {
        if (n_in != 35 || ws_size < WS_END) { fprintf(stderr, "kernel_launch: unexpected n_in %d / ws %zu\n", n_in, ws_size); grid_blocks = -1; return; }
        int dev = 0, cus = 0, per_cu = 0;
        hipGetDevice(&dev);
        hipDeviceGetAttribute(&cus, hipDeviceAttributeMultiprocessorCount, dev);
        if (hipFuncSetAttribute((const void*)mega_fwd, hipFuncAttributeMaxDynamicSharedMemorySize, LDS_BYTES) != hipSuccess) { fprintf(stderr, "kernel_launch: hipFuncSetAttribute failed\n"); }
        if (hipOccupancyMaxActiveBlocksPerMultiprocessor(&per_cu, (const void*)mega_fwd, 512, LDS_BYTES) != hipSuccess || per_cu < 1) { fprintf(stderr, "kernel_launch: occupancy query gave %d\n", per_cu); per_cu = 1; }
        (void)hipGetLastError();
        if (per_cu > 1) per_cu = 1;
        grid_blocks = cus * per_cu;
    }
    if (grid_blocks < 0) return;
    Params p{};
    for (int i = 0; i < 35; ++i) p.in[i] = (const float*)d_in[i];
    p.out = (float*)d_out; p.ws = (unsigned char*)d_ws;
    if (hipMemsetAsync((unsigned char*)d_ws + WS_BAR, 0, 16 * KiB, stream) != hipSuccess) { fprintf(stderr, "kernel_launch: memset of barrier words failed\n"); return; }
    void* args[] = {&p};
    hipError_t e = hipLaunchCooperativeKernel((const void*)mega_fwd, dim3(grid_blocks), dim3(512), args, LDS_BYTES, stream);
    if (e != hipSuccess) fprintf(stderr, "cooperative launch failed: %s (grid %d)\n", hipGetErrorString(e), grid_blocks);
}
```

```cpp
#include <hip/hip_runtime.h>
#include <hip/hip_cooperative_groups.h>
#include <cstdio>
#include <cstdint>
namespace cg = cooperative_groups;

#define LAS __attribute__((address_space(3)))
typedef unsigned short bf16_t;
typedef short bf16x8 __attribute__((ext_vector_type(8)));
typedef float f32x4 __attribute__((ext_vector_type(4)));
typedef float f32x16 __attribute__((ext_vector_type(16)));
typedef unsigned u32x4 __attribute__((ext_vector_type(4)));
typedef unsigned u32x2 __attribute__((ext_vector_type(2)));

constexpr int D = 1024, NB = 4, SEQ = 4096, CTXL = 256, PB = SEQ + CTXL  , MT = NB * PB  ;
constexpr int N_IN0 = 2304, DFF = 2816, N_IN1P = 1280, QLORA = 768, KVLORA = 256, NQ1 = 1536, NKV1 = 2048;
constexpr float LOG2E = 1.4426950408889634f;
constexpr float QS0 = 0.125f * LOG2E;
constexpr float QS1 = 0.10206207261596575f * LOG2E;
constexpr float ALPHA = 1.4142135623730951f;
constexpr float EPSF = 1e-6f;

constexpr size_t KiB = 1024, MiB = 1048576;
constexpr size_t WS_MOD = 0;
constexpr size_t WS_ROPE0 = 256 * KiB;
constexpr size_t WS_ROPE1 = 272 * KiB;
constexpr size_t WS_BAR = 512 * KiB;
constexpr size_t WS_W_IN0 = 1 * MiB;
constexpr size_t WS_W_OUT0 = WS_W_IN0 + 4608 * KiB;
constexpr size_t WS_W_UP0 = WS_W_OUT0 + 2 * MiB;
constexpr size_t WS_W_DN0 = WS_W_UP0 + 11 * MiB;
constexpr size_t WS_W_IN1 = WS_W_DN0 + 5632 * KiB;
constexpr size_t WS_W_UQ = WS_W_IN1 + 2560 * KiB;
constexpr size_t WS_W_UKV = WS_W_UQ + 2304 * KiB;
constexpr size_t WS_W_OUT1 = WS_W_UKV + 1 * MiB;
constexpr size_t WS_W_UP1 = WS_W_OUT1 + 2 * MiB;
constexpr size_t WS_W_DN1 = WS_W_UP1 + 11 * MiB;
constexpr size_t WS_XC = 49 * MiB;
constexpr size_t WS_H = 53 * MiB + 2048;
constexpr size_t WS_BIG = 88 * MiB;
constexpr size_t WS_RAW0 = WS_BIG;
constexpr size_t WS_KVC0 = 165 * MiB;
constexpr size_t WS_O0 = 208 * MiB;
constexpr size_t WS_Y0B = 122 * MiB;
constexpr size_t WS_YB = 182 * MiB;
constexpr size_t WS_RAW1B = 131 * MiB;
constexpr size_t WS_Y0 = WS_BIG;
constexpr size_t WS_Y = 221 * MiB;
constexpr size_t WS_U = WS_BIG;
constexpr size_t WS_RAW1 = WS_BIG;
constexpr size_t WS_CQ = 214 * MiB;
constexpr size_t WS_CKV = 240 * MiB;
constexpr size_t WS_KR = 249 * MiB;
constexpr size_t WS_KV1 = 139 * MiB;
constexpr size_t WS_Q1 = WS_BIG;
constexpr size_t WS_O1 = 214 * MiB;
constexpr size_t WS_Y1 = WS_BIG;
constexpr size_t WS_END = 256 * MiB;

#ifndef REP_ATT
#define REP_ATT 1
#endif
#ifndef KS_G2
#define KS_G2 1
#endif
#ifndef KS_G4
#define KS_G4 1
#endif
#ifndef KS_G5
#define KS_G5 1
#endif
#ifndef REP_UP
#define REP_UP 1
#endif
#ifndef REP_P0
#define REP_P0 1
#endif
#ifndef REP_SYNC
#define REP_SYNC 1
#endif
#define GRID_SYNC() do { for (int rs_ = 0; rs_ < REP_SYNC; ++rs_) { XcdBarrier xb_; xb_.bar = (unsigned*)(kargs()->ws + WS_BAR); xb_.x = xb_xcc_id(); xb_.st = (volatile LAS unsigned*)(lds + XLDS_OFF + 8192) + 8; xcd_barrier(xb_); } } while (0)
#ifndef REP_GEMM
#define REP_GEMM 1
#endif
constexpr int LDS_BYTES = 147456;
constexpr int XLDS_OFF = 131072;

__device__ __forceinline__ unsigned pk_bf16(float lo, float hi) {
    typedef float f2 __attribute__((ext_vector_type(2))); typedef __bf16 b2 __attribute__((ext_vector_type(2)));
    f2 v = {lo, hi}; b2 b = __builtin_convertvector(v, b2); return __builtin_bit_cast(unsigned, b);
}
__device__ __forceinline__ float bf_lo(unsigned w) { return __uint_as_float(w << 16); }
__device__ __forceinline__ float bf_hi(unsigned w) { return __uint_as_float(w & 0xffff0000u); }
__device__ __forceinline__ float wave_sum(float v) {
#pragma unroll
    for (int o = 1; o < 64; o <<= 1) v += __shfl_xor(v, o);
    return v;
}
#define LDS_WAIT() asm volatile("s_waitcnt lgkmcnt(0)" ::: "memory")
#define DPP_UPD(old, src, ctrl) __builtin_bit_cast(float, __builtin_amdgcn_update_dpp(__builtin_bit_cast(int, (float)(old)), __builtin_bit_cast(int, (float)(src)), (ctrl), 0xf, 0xf, false))
#define DPP_ROW_SHL1 0x101
#define DPP_ROW_SHR1 0x111
#define DPP_ROW_ROR1 0x121
#define DPP_ROW_ROR15 0x12f
__device__ __forceinline__ int otid() { int t = threadIdx.x; asm volatile("" : "+v"(t)); return t; }

namespace pg8 {
constexpr int BM = 256, BK = 64, HALF = 128, HTB = HALF * BK * 2, STAGE_BYTES = 8 * HTB, NXCD = 8, WGM = 8;
__host__ __device__ __forceinline__ int lds_byte(int r, int c) { const int st = (r >> 4) * 2 + (c >> 5), rr = r & 15, cc = c & 31, ob = rr * 64 + cc * 2; return st * 1024 + (ob ^ (((ob >> 9) & 1) << 5)); }
__host__ __device__ __forceinline__ void stage_rc(int b, int& R, int& C) { const int st = b / 1024, sb = b % 1024, swz = sb ^ (((sb >> 9) & 1) << 5); R = (st >> 1) * 16 + swz / 64; C = (st & 1) * 32 + (swz % 64) / 2; }
__host__ __device__ __forceinline__ int perm32(int rho) { const int n = rho >> 4, i = rho & 15; return 8 * (i >> 2) + 4 * n + (i & 3); }

struct Unit { int pm, pn, kh; };
struct Gemm { const bf16_t* A; const bf16_t* Bt; int K; int a_rows; int kpitch; };

struct StaticOrder {
    int nM, nN, nwg, G, c, skip, nNr, u0 = 0, u1 = 0x7fffffff;
    __device__ void init(int nM_, int nN_, int G_, int c_, int skip_, int ksplit = 1) { nM = nM_; nNr = nN_; nN = nN_ * ksplit; nwg = nM * nN; G = G_; c = c_; skip = skip_; }
    __device__ bool next(int i, Unit& u) const {
        const long L = (long)u0 + (long)i * G + c; if (L >= nwg || L >= u1) return false;
        int wgid = (int)L; { const int q = nwg / NXCD, r = nwg % NXCD, xcd = wgid % NXCD, off = wgid / NXCD; wgid = (xcd < r ? xcd * (q + 1) : r * (q + 1) + (xcd - r) * q) + off; }
        const int nig = WGM * nN, gid = wgid / nig, fm = gid * WGM, gsz = (nM - fm) < WGM ? (nM - fm) : WGM;
        u.pm = fm + ((wgid % nig) % gsz); u.pn = (wgid % nig) / gsz; u.kh = u.pn / nNr; u.pn -= u.kh * nNr;
        if (skip == 1) u.pm += u.pm >> 4;
        else if (skip == 2) u.pm = 16 + 17 * u.pm;
        return true;
    }
};

template <class Epi>
__device__ __forceinline__ void gemm_phase(LAS unsigned char* lds, const Gemm g, const StaticOrder& S, const Epi& E) {
    const int tid = otid(), wid = __builtin_amdgcn_readfirstlane(tid >> 6), lane = tid & 63, wr = wid >> 2, wc = wid & 3, fr = lane & 15, fq = lane >> 4;
    const int K = g.kpitch, nt = g.K / BK;
    unsigned voffA[2], voffB[2];
#pragma unroll
    for (int i = 0; i < 2; ++i) { int R, C; stage_rc(tid * 16 + i * 8192, R, C); const int Rb = ((R & ~31) + perm32(R & 31));
        voffA[i] = (unsigned)(R * K + C) * 2u; voffB[i] = (unsigned)(Rb * K + C) * 2u; }
    const size_t kstep = (size_t)(BK * 2);
    const size_t hstep = (size_t)HALF * K * 2;
    const size_t tstepB = 2 * hstep;
    const size_t tstepA = (size_t)g.a_rows * K * 2;
    const unsigned ldsw = (unsigned)wid * 1024u;
    const int aoff = lds_byte(wr * 64 + fr, fq * 8), boff = lds_byte(wc * 32 + fr, fq * 8);
#define PG8_SA(b, h) (((b) * 2 + (h)) * HTB)
#define PG8_SB(b, h) ((4 + (b) * 2 + (h)) * HTB)
#define PG8_STAGE(bufoff, gbase, voff) do { _Pragma("unroll") for (int _i = 0; _i < 2; ++_i) \
        __builtin_amdgcn_global_load_lds((const unsigned*)((const char*)(gbase) + (voff)[_i]), (LAS unsigned*)(lds + (bufoff) + ldsw + _i * 8192), 16, 0, 0); } while (0)
#define PG8_LDA(dst, b, h) do { _Pragma("unroll") for (int m = 0; m < 4; ++m) _Pragma("unroll") for (int k = 0; k < 2; ++k) dst[m][k] = *(const LAS bf16x8*)(lds + PG8_SA(b, h) + aoff + m * 2048 + k * 1024); } while (0)
#define PG8_LDB(dst, b, h) do { _Pragma("unroll") for (int n = 0; n < 2; ++n) _Pragma("unroll") for (int k = 0; k < 2; ++k) dst[n][k] = *(const LAS bf16x8*)(lds + PG8_SB(b, h) + boff + n * 2048 + k * 1024); } while (0)
#define PG8_MMA(ai, bj, At, Bt) do { __builtin_amdgcn_s_setprio(1); _Pragma("unroll") for (int m = 0; m < 4; ++m) _Pragma("unroll") for (int n = 0; n < 2; ++n) _Pragma("unroll") for (int k = 0; k < 2; ++k) \
        acc[ai][bj][m][n] = __builtin_amdgcn_mfma_f32_16x16x32_bf16(Bt[n][k], At[m][k], acc[ai][bj][m][n], 0, 0, 0); __builtin_amdgcn_s_setprio(0); } while (0)
#define PG8_WAIT_V(n) asm volatile("s_waitcnt vmcnt(" #n ")" ::: "memory")
#define PG8_WAIT_L(n) asm volatile("s_waitcnt lgkmcnt(" #n ")" ::: "memory")
#define PG8_BAR __builtin_amdgcn_s_barrier()
#define PG8_SCHED __builtin_amdgcn_sched_barrier(0)
    Unit cur, nxt; int ui = 0;
    if (!S.next(0, cur)) return;
    f32x4 acc[2][2][4][2];
#pragma unroll
    for (int a = 0; a < 2; ++a)
#pragma unroll
        for (int b = 0; b < 2; ++b)
#pragma unroll
            for (int m = 0; m < 4; ++m)
#pragma unroll
                for (int n = 0; n < 2; ++n) acc[a][b][m][n] = (f32x4){0.f, 0.f, 0.f, 0.f};
    bf16x8 At[4][2], B0[2][2], B1[2][2];
    const size_t khstep = (size_t)g.K * 2;
    const char* cA = (const char*)g.A + (size_t)cur.pm * tstepA + cur.kh * khstep; const char* cB = (const char*)g.Bt + (size_t)cur.pn * tstepB + cur.kh * khstep;
    PG8_STAGE(PG8_SB(0, 0), cB, voffB); PG8_STAGE(PG8_SB(0, 1), cB + hstep, voffB); PG8_STAGE(PG8_SA(0, 0), cA, voffA); PG8_STAGE(PG8_SA(0, 1), cA + hstep, voffA);
    if (wr == 1) PG8_BAR;
    PG8_WAIT_V(2); PG8_BAR;
    PG8_STAGE(PG8_SB(1, 0), cB + kstep, voffB); PG8_STAGE(PG8_SA(1, 0), cA + kstep, voffA); PG8_STAGE(PG8_SB(1, 1), cB + hstep + kstep, voffB);
    PG8_WAIT_V(6); PG8_BAR;
    for (;;) {
        const bool has_next = S.next(ui + 1, nxt);
        const char* nA = has_next ? (const char*)g.A + (size_t)nxt.pm * tstepA + nxt.kh * khstep : cA; const char* nB = has_next ? (const char*)g.Bt + (size_t)nxt.pn * tstepB + nxt.kh * khstep : cB;
#pragma nounroll
        for (int t = 0; t < nt; t += 2) {
            const bool last = (t == nt - 2);
            const char* a1 = cA + (size_t)(t + 1) * kstep;
            const char* a2 = last ? nA : cA + (size_t)(t + 2) * kstep; const char* b2 = last ? nB : cB + (size_t)(t + 2) * kstep;
            const char* a3 = a2 + kstep; const char* b3 = b2 + kstep;
            PG8_LDB(B0, 0, 0); PG8_LDB(B1, 0, 1); PG8_SCHED; PG8_LDA(At, 0, 0); PG8_STAGE(PG8_SA(1, 1), a1 + hstep, voffA);
            PG8_WAIT_V(8); PG8_WAIT_L(0); PG8_BAR; PG8_MMA(0, 0, At, B0); PG8_MMA(0, 1, At, B1); PG8_BAR; PG8_SCHED;
            PG8_LDA(At, 0, 1); PG8_STAGE(PG8_SB(0, 0), b2, voffB); PG8_STAGE(PG8_SB(0, 1), b2 + hstep, voffB); PG8_STAGE(PG8_SA(0, 0), a2, voffA);
            PG8_WAIT_V(8); PG8_WAIT_L(0); PG8_BAR; PG8_MMA(1, 0, At, B0); PG8_MMA(1, 1, At, B1); PG8_BAR; PG8_SCHED;
            PG8_LDB(B0, 1, 0); PG8_LDB(B1, 1, 1); PG8_SCHED; PG8_LDA(At, 1, 0); PG8_STAGE(PG8_SA(0, 1), a2 + hstep, voffA);
            PG8_WAIT_V(8); PG8_WAIT_L(0); PG8_BAR; PG8_MMA(0, 0, At, B0); PG8_MMA(0, 1, At, B1); PG8_BAR; PG8_SCHED;
            PG8_LDA(At, 1, 1); PG8_STAGE(PG8_SB(1, 0), b3, voffB); PG8_STAGE(PG8_SB(1, 1), b3 + hstep, voffB); PG8_STAGE(PG8_SA(1, 0), a3, voffA);
            PG8_WAIT_V(8); PG8_WAIT_L(0); PG8_BAR; PG8_MMA(1, 0, At, B0); PG8_MMA(1, 1, At, B1); PG8_BAR; PG8_SCHED;
        }
        if (wr == 0) PG8_BAR;
        E(acc, cur, wr, wc, fr, fq);
        if (!has_next) break;
#pragma unroll
        for (int a = 0; a < 2; ++a)
#pragma unroll
            for (int b = 0; b < 2; ++b)
#pragma unroll
                for (int m = 0; m < 4; ++m)
#pragma unroll
                    for (int n = 0; n < 2; ++n) acc[a][b][m][n] = (f32x4){0.f, 0.f, 0.f, 0.f};
        cur = nxt; cA = nA; cB = nB; ++ui;
        if (wr == 1) PG8_BAR;
    }
    PG8_WAIT_V(0);
    PG8_BAR;
#undef PG8_SA
#undef PG8_SB
#undef PG8_STAGE
#undef PG8_LDA
#undef PG8_LDB
#undef PG8_MMA
#undef PG8_WAIT_V
#undef PG8_WAIT_L
#undef PG8_BAR
#undef PG8_SCHED
}

struct EpiStore {
    bf16_t* O; int ldc; bf16_t* O2;
    __device__ __forceinline__ void operator()(const f32x4 (&acc)[2][2][4][2], const Unit& u, int wr, int wc, int fr, int fq) const {
        asm volatile("" : "+v"(fr), "+v"(fq));
        bf16_t* tb = (u.kh ? O2 : O) + (size_t)u.pm * BM * ldc + u.pn * BM;
        const unsigned off0 = (unsigned)(wr * 64 + fr) * (unsigned)ldc + (unsigned)(wc * 32 + 8 * fq);
#pragma unroll
        for (int ai = 0; ai < 2; ++ai)
#pragma unroll
            for (int m = 0; m < 4; ++m) { const unsigned offr = off0 + (unsigned)(ai * HALF + m * 16) * (unsigned)ldc;
#pragma unroll
                for (int bj = 0; bj < 2; ++bj) { const f32x4 v0 = acc[ai][bj][m][0], v1 = acc[ai][bj][m][1];
                    u32x4 w; w.x = pk_bf16(v0[0], v0[1]); w.y = pk_bf16(v0[2], v0[3]); w.z = pk_bf16(v1[0], v1[1]); w.w = pk_bf16(v1[2], v1[3]);
                    *(u32x4*)(tb + (offr + bj * HALF)) = w; } }
    }
};

struct EpiQkv0 {
    bf16_t* RAW; bf16_t* KVC; const float* qgain; const float* kgain; const float2* rope0; LAS float* SSQ;
    __device__ __forceinline__ void operator()(const f32x4 (&acc)[2][2][4][2], const Unit& u, int wr, int wc, int fr, int fq) const {
        asm volatile("" : "+v"(fr), "+v"(fq));
        const int rowt = u.pm * BM, b = rowt / PB, p0 = rowt - b * PB; const int rl0 = wr * 64 + fr;
        const bool lat = p0 < SEQ;
        const bool need_norm = (u.pn * BM) < 640;
        if (need_norm) {
#pragma unroll
            for (int bj = 0; bj < 2; ++bj)
#pragma unroll
                for (int ai = 0; ai < 2; ++ai)
#pragma unroll
                    for (int m = 0; m < 4; ++m) { const f32x4 v0 = acc[ai][bj][m][0], v1 = acc[ai][bj][m][1];
                        float ss = (v0[0] * v0[0] + v0[1] * v0[1]) + (v0[2] * v0[2] + v0[3] * v0[3]) + (v1[0] * v1[0] + v1[1] * v1[1]) + (v1[2] * v1[2] + v1[3] * v1[3]);
                        ss += __shfl_xor(ss, 16); ss += __shfl_xor(ss, 32);
                        if (fq == 0) SSQ[(bj * 256 + ai * HALF + rl0 + m * 16) * 4 + wc] = ss; }
        }
        LDS_WAIT(); __builtin_amdgcn_s_barrier(); asm volatile("" ::: "memory");
#pragma unroll
        for (int bj = 0; bj < 2; ++bj) {
            const int cg = u.pn * BM + bj * HALF + wc * 32;
            if (cg < 640) {
                const bool isq = cg < 512; const int hh = (cg >> 5) & 1;
                const float* gn = (isq ? qgain : kgain) + 32 * hh + 8 * fq; const f32x4 g0 = *(const f32x4*)gn, g1 = *(const f32x4*)(gn + 4);
                bf16_t* tb; unsigned pitch, off0;
                if (isq) { tb = RAW + (size_t)rowt * N_IN0 + cg; pitch = N_IN0; off0 = 8 * fq; }
                else { tb = KVC + ((size_t)(b * 20 + ((cg - 512) >> 6)) * PB + p0) * 64; pitch = 64; off0 = (cg & 63) + 8 * fq; }
                const float sc = isq ? QS0 : 1.f;
#pragma unroll
                for (int ai = 0; ai < 2; ++ai)
#pragma unroll
                    for (int m = 0; m < 4; ++m) { const int rl = rl0 + ai * HALF + m * 16;
                        const float tot = SSQ[(bj * 256 + rl) * 4 + wc] + SSQ[(bj * 256 + rl) * 4 + (wc ^ 1)];
                        const float rstd = __builtin_amdgcn_rsqf(tot * (1.f / 64.f) + EPSF) ;
                        f32x4 v0 = acc[ai][bj][m][0] * rstd * g0, v1 = acc[ai][bj][m][1] * rstd * g1;
                        if (lat) { const int p = p0 + rl; const int pos = hh ? (p & 63) : (p >> 6); const float2* cs = rope0 + pos * 16 + 4 * fq;
                            const float2 c0 = cs[0], c1 = cs[1], c2 = cs[2], c3 = cs[3]; f32x4 r0, r1;
                            r0[0] = v0[0] * c0.x - v0[1] * c0.y; r0[1] = v0[0] * c0.y + v0[1] * c0.x; r0[2] = v0[2] * c1.x - v0[3] * c1.y; r0[3] = v0[2] * c1.y + v0[3] * c1.x;
                            r1[0] = v1[0] * c2.x - v1[1] * c2.y; r1[1] = v1[0] * c2.y + v1[1] * c2.x; r1[2] = v1[2] * c3.x - v1[3] * c3.y; r1[3] = v1[2] * c3.y + v1[3] * c3.x;
                            v0 = r0; v1 = r1; }
                        v0 = v0 * sc; v1 = v1 * sc;
                        u32x4 w; w.x = pk_bf16(v0[0], v0[1]); w.y = pk_bf16(v0[2], v0[3]); w.z = pk_bf16(v1[0], v1[1]); w.w = pk_bf16(v1[2], v1[3]);
                        *(u32x4*)(tb + ((unsigned)rl * pitch + off0)) = w; }
            } else {
                const bool isqb = (cg >= 768 && cg < 1280);
                bf16_t* tb; unsigned pitch, off0;
                if (isqb) { tb = RAW + (size_t)rowt * N_IN0 + cg; pitch = N_IN0; off0 = 8 * fq; }
                else { const int hc = (cg < 768) ? 2 + ((cg - 640) >> 6) : (cg < 1792 ? 4 + ((cg - 1280) >> 6) : 12 + ((cg - 1792) >> 6));
                       tb = KVC + ((size_t)(b * 20 + hc) * PB + p0) * 64; pitch = 64; off0 = (cg & 63) + 8 * fq; }
                const float sc = isqb ? QS0 : 1.f;
#pragma unroll
                for (int ai = 0; ai < 2; ++ai)
#pragma unroll
                    for (int m = 0; m < 4; ++m) { const unsigned off = (unsigned)(rl0 + ai * HALF + m * 16) * pitch + off0; const f32x4 v0 = acc[ai][bj][m][0] * sc, v1 = acc[ai][bj][m][1] * sc;
                        u32x4 w; w.x = pk_bf16(v0[0], v0[1]); w.y = pk_bf16(v0[2], v0[3]); w.z = pk_bf16(v1[0], v1[1]); w.w = pk_bf16(v1[2], v1[3]);
                        *(u32x4*)(tb + off) = w; }
            }
        }
    }
};

struct EpiHeads {
    bf16_t* KVC; int nh;
    __device__ __forceinline__ void operator()(const f32x4 (&acc)[2][2][4][2], const Unit& u, int wr, int wc, int fr, int fq) const {
        asm volatile("" : "+v"(fr), "+v"(fq));
        const int rowt = u.pm * BM, b = rowt / PB, p0 = rowt - b * PB; const int rl0 = wr * 64 + fr;
#pragma unroll
        for (int bj = 0; bj < 2; ++bj) {
            const int cg = u.pn * BM + bj * HALF + wc * 32;
            bf16_t* tb = KVC + ((size_t)(b * nh + (cg >> 6)) * PB + p0) * 64; const unsigned off0 = (cg & 63) + 8 * fq;
#pragma unroll
            for (int ai = 0; ai < 2; ++ai)
#pragma unroll
                for (int m = 0; m < 4; ++m) { const unsigned off = (unsigned)(rl0 + ai * HALF + m * 16) * 64u + off0; const f32x4 v0 = acc[ai][bj][m][0], v1 = acc[ai][bj][m][1];
                    u32x4 w; w.x = pk_bf16(v0[0], v0[1]); w.y = pk_bf16(v0[2], v0[3]); w.z = pk_bf16(v1[0], v1[1]); w.w = pk_bf16(v1[2], v1[3]);
                    *(u32x4*)(tb + off) = w; }
        }
    }
};

struct EpiUq {
    bf16_t* Q1; const float2* rope1;
    __device__ __forceinline__ void operator()(const f32x4 (&acc)[2][2][4][2], const Unit& u, int wr, int wc, int fr, int fq) const {
        asm volatile("" : "+v"(fr), "+v"(fq));
        const int row0 = u.pm * BM + wr * 64 + fr;
#pragma unroll
        for (int bj = 0; bj < 2; ++bj) {
            const int c8 = u.pn * BM + bj * HALF + wc * 32 + 8 * fq, head = c8 / 96, within = c8 - head * 96;
            const bool rp = within >= 64; const int i0 = (within - 64) >> 1;
#pragma unroll
            for (int ai = 0; ai < 2; ++ai)
#pragma unroll
                for (int m = 0; m < 4; ++m) {
                    const int row = row0 + ai * HALF + m * 16; const int b = row / PB, p = row - b * PB;
                    f32x4 v0 = acc[ai][bj][m][0], v1 = acc[ai][bj][m][1];
                    if (rp) {
                        const int pos = (i0 < 8) ? (p >> 6) : (p & 63); const float2* cs = rope1 + pos * 8 + (i0 & 7);
                        const float2 c0 = cs[0], c1 = cs[1], c2 = cs[2], c3 = cs[3];
                        f32x4 r0, r1;
                        r0[0] = v0[0] * c0.x - v0[1] * c0.y; r0[1] = v0[0] * c0.y + v0[1] * c0.x;
                        r0[2] = v0[2] * c1.x - v0[3] * c1.y; r0[3] = v0[2] * c1.y + v0[3] * c1.x;
                        r1[0] = v1[0] * c2.x - v1[1] * c2.y; r1[1] = v1[0] * c2.y + v1[1] * c2.x;
                        r1[2] = v1[2] * c3.x - v1[3] * c3.y; r1[3] = v1[2] * c3.y + v1[3] * c3.x;
                        v0 = r0; v1 = r1;
                    }
                    v0 = v0 * QS1; v1 = v1 * QS1;
                    u32x4 w; w.x = pk_bf16(v0[0], v0[1]); w.y = pk_bf16(v0[2], v0[3]); w.z = pk_bf16(v1[0], v1[1]); w.w = pk_bf16(v1[2], v1[3]);
                    *(u32x4*)(Q1 + (size_t)u.pm * BM * NQ1 + ((unsigned)(row - u.pm * BM) * (unsigned)NQ1 + (unsigned)c8)) = w;
                }
        }
    }
};

struct EpiConvGlu {
    bf16_t* U; const float* cw; const float* cb; LAS float* XB;
    __device__ __forceinline__ void operator()(const f32x4 (&acc)[2][2][4][2], const Unit& u, int wr, int wc, int fr, int fq) const {
        asm volatile("" : "+v"(fr), "+v"(fq));
        const int lane = fq * 16 + fr, fl = wc * 32 + 8 * fq;
#pragma unroll
        for (int ai = 0; ai < 2; ++ai) { const int s = 2 * ai + wr;
            if (fr == 0) {
#pragma unroll
                for (int n = 0; n < 2; ++n)
#pragma unroll
                    for (int j = 0; j < 4; ++j) XB[(s * 2 + 0) * 128 + fl + 4 * n + j] = acc[ai][0][0][n][j]; }
            if (fr == 15) {
#pragma unroll
                for (int n = 0; n < 2; ++n)
#pragma unroll
                    for (int j = 0; j < 4; ++j) XB[(s * 2 + 1) * 128 + fl + 4 * n + j] = acc[ai][0][3][n][j]; }
        }
        LDS_WAIT(); __builtin_amdgcn_s_barrier(); asm volatile("" ::: "memory");
        const int fg = u.pn * 128 + fl;
        f32x4 w0[2], w1[2], w2[2], bb[2];
#pragma unroll
        for (int n = 0; n < 2; ++n) { w0[n] = *(const f32x4*)(cw + fg + 4 * n); w1[n] = *(const f32x4*)(cw + DFF + fg + 4 * n); w2[n] = *(const f32x4*)(cw + 2 * DFF + fg + 4 * n); bb[n] = *(const f32x4*)(cb + fg + 4 * n); }
#pragma unroll
        for (int ai = 0; ai < 2; ++ai) { const int s = 2 * ai + wr;
#pragma unroll
            for (int m = 0; m < 4; ++m) {
                const int rl = ai * HALF + wr * 64 + m * 16 + fr; const int grow = u.pm * 254 - 1 + rl;
                const int p = (grow >= 0) ? (grow % PB) : -1;
                const bool first = (p == 0) || (p == SEQ), lastr = (p == SEQ - 1) || (p == PB - 1);
                unsigned ow[4];
#pragma unroll
                for (int n = 0; n < 2; ++n) {
                    const f32x4 g = acc[ai][0][m][n], v = acc[ai][1][m][n]; float r[4];
#pragma unroll
                    for (int j = 0; j < 4; ++j) {
                        float tu, td;
                        if (m > 0) tu = DPP_UPD(0.f, acc[ai][0][m > 0 ? m - 1 : 0][n][j], DPP_ROW_ROR1);
                        else tu = (s > 0) ? XB[((s > 0 ? s - 1 : 0) * 2 + 1) * 128 + fl + 4 * n + j] : 0.f;
                        float up = DPP_UPD(tu, g[j], DPP_ROW_SHR1); if (first) up = 0.f;
                        if (m < 3) td = DPP_UPD(0.f, acc[ai][0][m < 3 ? m + 1 : 3][n][j], DPP_ROW_ROR15);
                        else td = (s < 3) ? XB[((s < 3 ? s + 1 : 3) * 2 + 0) * 128 + fl + 4 * n + j] : 0.f;
                        float dn = DPP_UPD(td, g[j], DPP_ROW_SHL1); if (lastr) dn = 0.f;
                        const float gc = w0[n][j] * up + w1[n][j] * g[j] + w2[n][j] * dn + bb[n][j];
                        const float sg = gc * __builtin_amdgcn_rcpf(1.f + __expf(-gc));
                        r[j] = sg * v[j];
                    }
                    ow[2 * n] = pk_bf16(r[0], r[1]); ow[2 * n + 1] = pk_bf16(r[2], r[3]);
                }
                if (rl >= 1 && rl <= 254 && grow < MT) { u32x4 w; w.x = ow[0]; w.y = ow[1]; w.z = ow[2]; w.w = ow[3]; *(u32x4*)(U + ((size_t)(u.pm * 254) * DFF + u.pn * 128) + (unsigned)((rl - 1) * DFF + fl)) = w; }
                __builtin_amdgcn_sched_barrier(0);
            }
        }
    }
};
}

__device__ __forceinline__ u32x4 gload16(const void* p) { u32x4 r; asm volatile("global_load_dwordx4 %0, %1, off" : "=&v"(r) : "v"(p) : "memory"); return r; }
__device__ __forceinline__ float max3f(float a, float b, float c) { float r; asm("v_max3_f32 %0, %1, %2, %3" : "=v"(r) : "v"(a), "v"(b), "v"(c)); return r; }
__device__ __forceinline__ int crow(int r, int hi) { return (r & 3) + 8 * (r >> 2) + 4 * hi; }
constexpr int AT_KBUF = 8192 + 4096, AT_VBUF = 8192, AT_VOFF = 4 * AT_KBUF, AT_RPB = AT_VOFF + 4 * AT_VBUF;
typedef short v4i16 __attribute__((ext_vector_type(4)));
__device__ __forceinline__ v4i16 vtr(LAS const unsigned char* p) { return __builtin_amdgcn_ds_read_tr16_b64_v4i16((LAS v4i16*)p); }

template <int DK, bool NA>
__device__ __forceinline__ void attn_unit(LAS unsigned char* lds, const bf16_t* Qp, int qpitch, const bf16_t* Kp, int kpitch, const bf16_t* KRp,
                                          const bf16_t* Vp, int vpitch, bf16_t* Op, int ta0, int ta1, int tb0, int tb1, int r0, const float* rpbh) {
    constexpr int KS = DK / 16;
    constexpr float THR = 8.f;
    const int tid = otid(), lane = tid & 63, wid = __builtin_amdgcn_readfirstlane(tid >> 6), r32 = lane & 31, hi = lane >> 5;
    LAS float* RPB = (LAS float*)(lds + AT_RPB);
    if (NA) { for (int i = tid; i < 465; i += 512) RPB[i] = rpbh[i] * LOG2E; }
    bf16x8 qf[KS];
    { const bf16_t* qrow = Qp + (size_t)(32 * wid + r32) * qpitch + 8 * hi;
#pragma unroll
      for (int s = 0; s < KS; ++s) qf[s] = *(const bf16x8*)(qrow + 16 * s); }
    const int srow = 8 * wid + (lane >> 3);
    const bf16_t* kg = Kp + (size_t)srow * kpitch + 8 * ((lane & 7) ^ ((srow >> 1) & 7));
    const bf16_t* vg = Vp + (size_t)srow * vpitch + 8 * ((lane & 7) ^ (((srow >> 1) & 1) << 2));
    const int rrow = 16 * (wid & 3) + (lane >> 2);
    const bf16_t* krg = (DK == 96) ? (KRp + (size_t)rrow * 32 + 8 * ((lane & 3) ^ ((rrow >> 2) & 3))) : Kp;
    const int na = ta1 - ta0, nt = na + (tb1 - tb0);
#define AT_TILE(i) (((i) < na) ? ta0 + (i) : tb0 + ((i) - na))
#define AT_ACT(kt) (!NA || (kt) >= 64 || ((kt) >= rs && (kt) < rs + 8))
#define AT_GLDS(gp, ldsoff) __builtin_amdgcn_global_load_lds((const unsigned*)(gp), (LAS unsigned*)(lds + (ldsoff)), 16, 0, 0)
#define AT_DMAK(kt, sl) do { AT_GLDS(kg + (size_t)(kt) * 64 * kpitch, (sl) * AT_KBUF + wid * 1024); if (DK == 96 && wid < 4) AT_GLDS(krg + (size_t)(kt) * 64 * 32, (sl) * AT_KBUF + 8192 + wid * 1024); } while (0)
#define AT_DMAV(kt, sl) AT_GLDS(vg + (size_t)(kt) * 64 * vpitch, AT_VOFF + (sl) * AT_VBUF + wid * 1024)
    int koff[KS];
#pragma unroll
    for (int s = 0; s < KS; ++s) koff[s] = (s < 4) ? (r32 * 128 + ((((2 * s + hi) ^ ((r32 >> 1) & 7))) << 4)) : (8192 + r32 * 64 + ((((2 * (s - 4) + hi) ^ ((r32 >> 2) & 3))) << 4));
#define AT_QK(bi, d0, d1) do { LAS const unsigned char* kb_ = lds + (bi) * AT_KBUF; \
        _Pragma("unroll") for (int s = 0; s < KS; ++s) { \
            const bf16x8 k0_ = *(LAS const bf16x8*)(kb_ + koff[s]); \
            const bf16x8 k1_ = *(LAS const bf16x8*)(kb_ + koff[s] + ((s < 4) ? 4096 : 2048)); \
            if (s == 0) { d0 = __builtin_amdgcn_mfma_f32_32x32x16_bf16(k0_, qf[0], negm, 0, 0, 0); d1 = __builtin_amdgcn_mfma_f32_32x32x16_bf16(k1_, qf[0], negm, 0, 0, 0); } \
            else { d0 = __builtin_amdgcn_mfma_f32_32x32x16_bf16(k0_, qf[s], d0, 0, 0, 0); d1 = __builtin_amdgcn_mfma_f32_32x32x16_bf16(k1_, qf[s], d1, 0, 0, 0); } } } while (0)
    float m_ref = 0.f, l_run = 0.f;
    f32x16 o0, o1, negm, sA0, sA1, sB0, sB1;
#pragma unroll
    for (int r = 0; r < 16; ++r) { o0[r] = 0.f; o1[r] = 0.f; negm[r] = 0.f; }
    const int c = 32 * (wid & 1) + r32, cs = min(max(c - 8, 0), 48), rq = r0 + (wid >> 1), rs = min(max(rq - 4, 0), 56);
    const int vrow_l = 4 * (lane >> 5) + ((lane & 15) >> 2), vflip = (vrow_l >> 1) & 1, vc0 = 2 * ((lane >> 4) & 1) + ((lane & 3) >> 1);
    const int vfo0 = AT_VOFF + vrow_l * 128 + ((vc0 + 4 * (0 ^ vflip)) << 4) + 8 * (lane & 1);
    const int vfo1 = AT_VOFF + vrow_l * 128 + ((vc0 + 4 * (1 ^ vflip)) << 4) + 8 * (lane & 1);
    { const int kt0 = AT_TILE(0); AT_DMAK(kt0, 0); AT_DMAV(kt0, 0);
      if (nt > 1) { const int kt1 = AT_TILE(1); AT_DMAK(kt1, 1); AT_DMAV(kt1, 1); }
      if (nt > 2) { const int kt2 = AT_TILE(2); AT_DMAK(kt2, 2); }
      asm volatile("s_waitcnt vmcnt(0) lgkmcnt(0)" ::: "memory"); __builtin_amdgcn_s_barrier(); asm volatile("" ::: "memory");
      if (AT_ACT(kt0)) AT_QK(0, sA0, sA1); }
#define AT_STEP(C0, C1, N0, N1, I) do { \
        const int i_ = (I); const int kt = AT_TILE(i_); \
        const bool act = AT_ACT(kt), has1 = (i_ + 1 < nt); \
        const bool actn = has1 && AT_ACT(AT_TILE(has1 ? i_ + 1 : i_)); \
        if (actn) AT_QK((i_ + 1) & 3, N0, N1); \
        float dl = 0.f; bool bumped = false; \
        if (act) { \
            if (NA && kt < 64) { \
                const int ro = (kt - rq + 7) * 31 - c + 15; \
                _Pragma("unroll") for (int r = 0; r < 16; ++r) { \
                    const int kc = crow(r, hi); \
                    const bool ok0 = (kc >= cs) && (kc < cs + 16), ok1 = (kc + 32 >= cs) && (kc + 32 < cs + 16); \
                    const float b0 = RPB[min(max(ro + kc, 0), 464)], b1 = RPB[min(max(ro + kc + 32, 0), 464)];     \
                    C0[r] = ok0 ? C0[r] + b0 : -1e30f; C1[r] = ok1 ? C1[r] + b1 : -1e30f; } \
            } \
            float mxa = max3f(C0[0], C0[1], C1[0]), mxb = max3f(C0[2], C0[3], C1[1]); mxa = max3f(mxa, C1[2], C1[3]); \
            _Pragma("unroll") for (int r = 4; r < 16; r += 4) { mxa = max3f(mxa, C0[r], C0[r + 1]); mxb = max3f(mxb, C0[r + 2], C0[r + 3]); mxa = max3f(mxa, C1[r], C1[r + 1]); mxb = max3f(mxb, C1[r + 2], C1[r + 3]); } \
            float mx = max3f(mxa, mxb, mxb); { const auto rr_ = __builtin_amdgcn_permlane32_swap(__float_as_uint(mx), __float_as_uint(mx), false, false); mx = max3f(__uint_as_float(rr_[0]), __uint_as_float(rr_[1]), mx); }     \
            bumped = __any(mx > THR) != 0; \
            if (bumped) { \
                dl = max3f(mx, 0.f, 0.f); m_ref += dl; \
                const float al = __builtin_amdgcn_exp2f(-dl); \
                l_run *= al; \
                _Pragma("unroll") for (int r = 0; r < 16; ++r) { C0[r] -= dl; C1[r] -= dl; o0[r] *= al; o1[r] *= al; negm[r] = -m_ref; } \
            } \
            float ra = 0.f, rb = 0.f, rc = 0.f, rd = 0.f; \
            _Pragma("unroll") for (int r = 0; r < 16; r += 2) { C0[r] = __builtin_amdgcn_exp2f(C0[r]); C1[r] = __builtin_amdgcn_exp2f(C1[r]); C0[r + 1] = __builtin_amdgcn_exp2f(C0[r + 1]); C1[r + 1] = __builtin_amdgcn_exp2f(C1[r + 1]); \
                ra += C0[r]; rb += C1[r]; rc += C0[r + 1]; rd += C1[r + 1]; } \
            l_run += (ra + rb) + (rc + rd); \
            bf16x8 pf[2][2]; \
            { u32x4 w; \
              w.x = pk_bf16(C0[0], C0[1]); w.y = pk_bf16(C0[2], C0[3]); w.z = pk_bf16(C0[4], C0[5]); w.w = pk_bf16(C0[6], C0[7]); pf[0][0] = __builtin_bit_cast(bf16x8, w); \
              w.x = pk_bf16(C0[8], C0[9]); w.y = pk_bf16(C0[10], C0[11]); w.z = pk_bf16(C0[12], C0[13]); w.w = pk_bf16(C0[14], C0[15]); pf[0][1] = __builtin_bit_cast(bf16x8, w); \
              w.x = pk_bf16(C1[0], C1[1]); w.y = pk_bf16(C1[2], C1[3]); w.z = pk_bf16(C1[4], C1[5]); w.w = pk_bf16(C1[6], C1[7]); pf[1][0] = __builtin_bit_cast(bf16x8, w); \
              w.x = pk_bf16(C1[8], C1[9]); w.y = pk_bf16(C1[10], C1[11]); w.z = pk_bf16(C1[12], C1[13]); w.w = pk_bf16(C1[14], C1[15]); pf[1][1] = __builtin_bit_cast(bf16x8, w); } \
            LAS const unsigned char* vb = lds + (i_ & 3) * AT_VBUF; \
            _Pragma("unroll") for (int blk = 0; blk < 2; ++blk) \
                _Pragma("unroll") for (int sp = 0; sp < 2; ++sp) { \
                    const int off = (32 * blk + 16 * sp) * 128; \
                    const v4i16 a0 = vtr(vb + vfo0 + off), a1 = vtr(vb + vfo0 + off + 8 * 128); \
                    const v4i16 d0 = vtr(vb + vfo1 + off), d1 = vtr(vb + vfo1 + off + 8 * 128); \
                    const bf16x8 vf0 = (bf16x8){a0[0], a0[1], a0[2], a0[3], a1[0], a1[1], a1[2], a1[3]}; \
                    const bf16x8 vf1 = (bf16x8){d0[0], d0[1], d0[2], d0[3], d1[0], d1[1], d1[2], d1[3]}; \
                    o0 = __builtin_amdgcn_mfma_f32_32x32x16_bf16(vf0, pf[blk][sp], o0, 0, 0, 0); \
                    o1 = __builtin_amdgcn_mfma_f32_32x32x16_bf16(vf1, pf[blk][sp], o1, 0, 0, 0); } \
        } \
        if (actn && bumped) { _Pragma("unroll") for (int r = 0; r < 16; ++r) { N0[r] -= dl; N1[r] -= dl; } }     \
    } while (0)
    for (int i = 0; i < nt; i += 2) {
        if (i + 3 < nt) { const int kt3 = AT_TILE(i + 3); AT_DMAK(kt3, (i + 3) & 3); AT_DMAV(kt3, (i + 3) & 3); }
        if (i + 4 < nt) { const int kt4 = AT_TILE(i + 4); AT_DMAK(kt4, (i + 4) & 3); }
        if (i + 2 < nt) { const int kt2 = AT_TILE(i + 2); AT_DMAV(kt2, (i + 2) & 3); }
        AT_STEP(sA0, sA1, sB0, sB1, i);
        if (i + 1 < nt) AT_STEP(sB0, sB1, sA0, sA1, i + 1);
        asm volatile("s_waitcnt vmcnt(0) lgkmcnt(0)" ::: "memory"); __builtin_amdgcn_s_barrier(); asm volatile("" ::: "memory");
    }
    __syncthreads();
#undef AT_STEP
#undef AT_TILE
#undef AT_ACT
#undef AT_GLDS
#undef AT_DMAK
#undef AT_DMAV
#undef AT_QK
    l_run += __shfl_xor(l_run, 32);
    const float inv = 1.f / l_run;
    bf16_t* orow = Op + (size_t)(32 * wid + r32) * 1024 + 8 * hi;
#pragma unroll
    for (int gp = 0; gp < 2; ++gp)
#pragma unroll
        for (int db = 0; db < 2; ++db) {
            const int g = 2 * gp;
            unsigned ax, ay, bx_, by;
            if (db == 0) { ax = pk_bf16(o0[4 * g] * inv, o0[4 * g + 1] * inv); ay = pk_bf16(o0[4 * g + 2] * inv, o0[4 * g + 3] * inv);
                           bx_ = pk_bf16(o0[4 * g + 4] * inv, o0[4 * g + 5] * inv); by = pk_bf16(o0[4 * g + 6] * inv, o0[4 * g + 7] * inv); }
            else { ax = pk_bf16(o1[4 * g] * inv, o1[4 * g + 1] * inv); ay = pk_bf16(o1[4 * g + 2] * inv, o1[4 * g + 3] * inv);
                   bx_ = pk_bf16(o1[4 * g + 4] * inv, o1[4 * g + 5] * inv); by = pk_bf16(o1[4 * g + 6] * inv, o1[4 * g + 7] * inv); }
            const auto sx = __builtin_amdgcn_permlane32_swap(ax, bx_, false, false);
            const auto sy = __builtin_amdgcn_permlane32_swap(ay, by, false, false);
            u32x4 w; w.x = sx[0]; w.y = sy[0]; w.z = sx[1]; w.w = sy[1];
            *(u32x4*)(orow + 32 * db + 16 * gp) = w;
        }
}

#define XB_TMO      128
#define XB_XCNT(j)  (256  + 64 * (j))
#define XB_XSUB(j)  (1280 + 64 * (j))
#define XB_XGEN(j)  (2304 + 64 * (j))
#define XB_TOP      3328
#define XB_TOPGEN   3392
#define XCD_BAR_WORDS 3456
#define XB_SPIN_CAP (1u << 18)
__device__ __forceinline__ unsigned xb_ld(unsigned* p)              { return __hip_atomic_load(p, __ATOMIC_RELAXED, __HIP_MEMORY_SCOPE_AGENT); }
__device__ __forceinline__ unsigned xb_add(unsigned* p, unsigned v) { return __hip_atomic_fetch_add(p, v, __ATOMIC_RELAXED, __HIP_MEMORY_SCOPE_AGENT); }
__device__ __forceinline__ unsigned xb_xcc_id() { return (unsigned)__builtin_amdgcn_s_getreg((3 << 11) | 20) & 0xFu; }
#define XB_SPIN(cond, bar) do { unsigned _sp = 0; while (cond) { __builtin_amdgcn_s_sleep(1); \
    if ((++_sp & 255u) == 0u) { if (xb_ld(&(bar)[XB_TMO])) break; if (_sp > XB_SPIN_CAP) { atomicAdd(&(bar)[XB_TMO], 1u); break; } } } } while (0)
struct XcdBarrier { unsigned* bar; unsigned x; volatile LAS unsigned* st; };
__device__ __forceinline__ void xcd_barrier_complete(unsigned* bar, unsigned x, unsigned& nloc, unsigned& nx) {
    const unsigned G = gridDim.x * gridDim.y * gridDim.z;
    unsigned sum, cnt, mine, sp = 0u;
    for (;;) {
        sum = 0u; cnt = 0u; mine = 0u;
#pragma unroll
        for (unsigned j = 0; j < 16; ++j) { const unsigned c = xb_ld(&bar[XB_XCNT(j)]); sum += c; cnt += (c > 0u) ? 1u : 0u; mine = (j == x) ? c : mine; }
        if (sum == G) break;
        __builtin_amdgcn_s_sleep(1);
        if ((++sp & 255u) == 0u) { if (xb_ld(&bar[XB_TMO])) break; if (sp > XB_SPIN_CAP) { atomicAdd(&bar[XB_TMO], 1u); break; } }
    }
    nloc = mine > 0u ? mine : 1u; nx = cnt > 0u ? cnt : 1u;
}
__device__ __forceinline__ void xcd_barrier(const XcdBarrier& b) {
    asm volatile("s_waitcnt vmcnt(0)" ::: "memory");
    __syncthreads();
    if (threadIdx.x == 0) {
        unsigned* bar = b.bar;
        __builtin_amdgcn_s_waitcnt(0);
        unsigned nloc = b.st[0], nx = b.st[1];
        if (nloc == 0u) { xcd_barrier_complete(bar, b.x, nloc, nx); b.st[0] = nloc; b.st[1] = nx; }
        const unsigned old = xb_add(&bar[XB_XSUB(b.x)], 1u);
        const unsigned gen = old / nloc;
        if (old + 1u == (gen + 1u) * nloc) {
            __builtin_amdgcn_fence(__ATOMIC_RELEASE, "agent");
            asm volatile("s_waitcnt vmcnt(0)" ::: "memory");
            const unsigned og = xb_add(&bar[XB_TOP], 1u);
            const unsigned tg = og / nx;
            if (og + 1u == (tg + 1u) * nx) xb_add(&bar[XB_TOPGEN], 1u);
            else XB_SPIN(xb_ld(&bar[XB_TOPGEN]) == tg, bar);
            __builtin_amdgcn_fence(__ATOMIC_ACQUIRE, "agent");
            xb_add(&bar[XB_XGEN(b.x)], 1u);
            asm volatile("s_waitcnt vmcnt(0)" ::: "memory");
        } else {
            XB_SPIN(xb_ld(&bar[XB_XGEN(b.x)]) == gen, bar);
            __builtin_amdgcn_fence(__ATOMIC_ACQUIRE, "agent");
            asm volatile("s_waitcnt vmcnt(0)" ::: "memory");
        }
    }
    __syncthreads();
}

__device__ __forceinline__ void sub_barrier(unsigned* cnt, unsigned n) {
    asm volatile("s_waitcnt vmcnt(0)" ::: "memory");
    __syncthreads();
    if (threadIdx.x == 0) {
        __builtin_amdgcn_fence(__ATOMIC_RELEASE, "agent");
        asm volatile("s_waitcnt vmcnt(0)" ::: "memory");
        (void)xb_add(cnt, 1u);
        unsigned sp = 0u; while (xb_ld(cnt) < n) { __builtin_amdgcn_s_sleep(1); if (++sp > (1u << 22)) break; }
        __builtin_amdgcn_fence(__ATOMIC_ACQUIRE, "agent");
        asm volatile("s_waitcnt vmcnt(0)" ::: "memory");
    }
    __syncthreads();
}

struct Params { const float* in[35]; float* out; unsigned char* ws; };

__device__ __forceinline__ void transpose_item(const float* __restrict__ W, int K, int N, bf16_t* WT, int mode, LAS float* scr, int item, int lane) {
    const int nblk = N / 32, kb = item / nblk, nb = item % nblk, k0 = 64 * kb, n0 = 32 * nb;
    float tv[32];
#pragma unroll
    for (int i = 0; i < 32; ++i) tv[i] = W[(size_t)(k0 + 2 * i + (lane >> 5)) * N + n0 + (lane & 31)];
#pragma unroll
    for (int i = 0; i < 32; ++i) scr[(2 * i + (lane >> 5)) * 33 + (lane & 31)] = tv[i];
    LDS_WAIT();
    int n0d = n0;
    if (mode == 1) { if (n0 < DFF) n0d = (n0 >> 7) * 256 + (n0 & 127); else { const int f = n0 - DFF; n0d = (f >> 7) * 256 + 128 + (f & 127); } }
    const int c = lane & 7;
#pragma unroll
    for (int j = 0; j < 4; ++j) { const int n = (lane >> 3) + 8 * j; const LAS float* s = scr + (8 * c) * 33 + n;
        u32x4 o; o.x = pk_bf16(s[0 * 33], s[1 * 33]); o.y = pk_bf16(s[2 * 33], s[3 * 33]); o.z = pk_bf16(s[4 * 33], s[5 * 33]); o.w = pk_bf16(s[6 * 33], s[7 * 33]);
        *(u32x4*)(WT + (size_t)(n0d + n) * K + k0 + 8 * c) = o; }
    LDS_WAIT();
}

__device__ __forceinline__ float* xr_row(float* out, float* xc, int b, int p) { return (p < SEQ) ? out + (size_t)(b * SEQ + p) * D : xc + (size_t)(b * CTXL + (p - SEQ)) * D; }

__device__ __forceinline__ void ln_phase(const float* src_lat, const float* src_ctx, float* out, float* xc, const bf16_t* Y, const bf16_t* Y2, const float* mod_l, int gchunk,
                                         const float* lg, const float* lb, const float* mod_next, int nchunk_sh, bf16_t* H, int mode  , int gw, int ngw, int lane) {
    constexpr int NR = 4;
    const int nrows = (mode == 0) ? NB * SEQ : (mode == 1 ? MT : NB * CTXL);
    for (int r0_ = gw; r0_ < nrows; r0_ += NR * ngw) {
        int bb[NR], pp[NR], rowi[NR], cnd[NR]; const float* srcp[NR]; bool ok[NR];
#pragma unroll
        for (int t = 0; t < NR; ++t) { ok[t] = (r0_ + t * ngw) < nrows; const int r_ = ok[t] ? r0_ + t * ngw : r0_;
            int b, p; if (mode == 0) { b = r_ >> 12; p = r_ & (SEQ - 1); } else if (mode == 1) { b = r_ / PB; p = r_ - b * PB; } else { b = r_ >> 8; p = SEQ + (r_ & (CTXL - 1)); }
            bb[t] = b; pp[t] = p; rowi[t] = b * PB + p; cnd[t] = (p < SEQ) ? b : 4;
            srcp[t] = (p < SEQ) ? src_lat + (size_t)(b * SEQ + p) * D : src_ctx + (size_t)(b * CTXL + (p - SEQ)) * D; }
        f32x4 v[NR][4]; float s[NR];
#pragma unroll
        for (int t = 0; t < NR; ++t) { const float* gv = mod_l + (size_t)cnd[t] * 6144 + gchunk * 1024; s[t] = 0.f;
#pragma unroll
            for (int j = 0; j < 4; ++j) { const int col = 4 * lane + 256 * j; const f32x4 x = *(const f32x4*)(srcp[t] + col), g = *(const f32x4*)(gv + col);
                const u32x2 yw = *(const u32x2*)(Y + (size_t)rowi[t] * D + col);
                f32x4 y; y[0] = bf_lo(yw.x); y[1] = bf_hi(yw.x); y[2] = bf_lo(yw.y); y[3] = bf_hi(yw.y);
                if (Y2) { const u32x2 zw = *(const u32x2*)(Y2 + (size_t)rowi[t] * D + col); y[0] += bf_lo(zw.x); y[1] += bf_hi(zw.x); y[2] += bf_lo(zw.y); y[3] += bf_hi(zw.y); }
                v[t][j] = x * ALPHA + g * y; s[t] += (v[t][j][0] + v[t][j][1]) + (v[t][j][2] + v[t][j][3]); } }
        float s2[NR], rstd[NR];
#pragma unroll
        for (int o = 1; o < 64; o <<= 1) {
#pragma unroll
            for (int t = 0; t < NR; ++t) s[t] += __shfl_xor(s[t], o); }
#pragma unroll
        for (int t = 0; t < NR; ++t) { const float mean = s[t] * (1.f / D); s2[t] = 0.f;
#pragma unroll
            for (int j = 0; j < 4; ++j) { v[t][j] = v[t][j] - mean; s2[t] += (v[t][j][0] * v[t][j][0] + v[t][j][1] * v[t][j][1]) + (v[t][j][2] * v[t][j][2] + v[t][j][3] * v[t][j][3]); } }
#pragma unroll
        for (int o = 1; o < 64; o <<= 1) {
#pragma unroll
            for (int t = 0; t < NR; ++t) s2[t] += __shfl_xor(s2[t], o); }
#pragma unroll
        for (int t = 0; t < NR; ++t) rstd[t] = 1.f / sqrtf(s2[t] * (1.f / D) + EPSF);
#pragma unroll
        for (int t = 0; t < NR; ++t) {
            if (ok[t]) {
                float* dst = xr_row(out, xc, bb[t], pp[t]);
#pragma unroll
                for (int j = 0; j < 4; ++j) { const int col = 4 * lane + 256 * j; const f32x4 o = v[t][j] * rstd[t] * *(const f32x4*)(lg + col) + *(const f32x4*)(lb + col);
                    *(f32x4*)(dst + col) = o;
                    if (mod_next) { const float* mn = mod_next + (size_t)cnd[t] * 6144; const f32x4 sh = *(const f32x4*)(mn + nchunk_sh * 1024 + col), sc = *(const f32x4*)(mn + (nchunk_sh + 1) * 1024 + col);
                        const f32x4 h = o * (sc + 1.f) + sh; u32x2 w; w.x = pk_bf16(h[0], h[1]); w.y = pk_bf16(h[2], h[3]); *(u32x2*)(H + (size_t)rowi[t] * D + col) = w; } }
            }
        }
    }
}

typedef const Params __attribute__((address_space(4)))* KP;
__device__ __forceinline__ KP kargs() { KP p = (KP)__builtin_amdgcn_kernarg_segment_ptr(); asm volatile("" : "+s"(p)); return p; }
__device__ __forceinline__ void convert_items(KP kp, unsigned char* ws, LAS unsigned char* lds, int lane, int wid, int lo, int hi, int wrank, int nw) {
    LAS float* scr = (LAS float*)(lds + wid * 8704);
    constexpr int I0 = 16 * 72, I1 = 16 * 32, I2 = 16 * 176, I3 = 44 * 32, I4 = 16 * 33, I5 = 12 * 48, I6 = 4 * 64;
    for (int it = lo + wrank; it < hi; it += nw) {
        int r = it;
        if (r < I0) { transpose_item(kp->in[6], 1024, N_IN0, (bf16_t*)(ws + WS_W_IN0), 0, scr, r, lane); continue; } r -= I0;
        if (r < I1) { transpose_item(kp->in[10], 1024, 1024, (bf16_t*)(ws + WS_W_OUT0), 0, scr, r, lane); continue; } r -= I1;
        if (r < I2) { transpose_item(kp->in[13], 1024, 2 * DFF, (bf16_t*)(ws + WS_W_UP0), 1, scr, r, lane); continue; } r -= I2;
        if (r < I3) { transpose_item(kp->in[16], DFF, 1024, (bf16_t*)(ws + WS_W_DN0), 0, scr, r, lane); continue; } r -= I3;
        if (r < I4) { transpose_item(kp->in[21], 1024, 1056, (bf16_t*)(ws + WS_W_IN1), 0, scr, r, lane); continue; } r -= I4;
        if (r < I5) { transpose_item(kp->in[24], QLORA, NQ1, (bf16_t*)(ws + WS_W_UQ), 0, scr, r, lane); continue; } r -= I5;
        if (r < I6) { transpose_item(kp->in[25], KVLORA, NKV1, (bf16_t*)(ws + WS_W_UKV), 0, scr, r, lane); continue; } r -= I6;
        if (r < I1) { transpose_item(kp->in[26], 1024, 1024, (bf16_t*)(ws + WS_W_OUT1), 0, scr, r, lane); continue; } r -= I1;
        if (r < I2) { transpose_item(kp->in[29], 1024, 2 * DFF, (bf16_t*)(ws + WS_W_UP1), 1, scr, r, lane); continue; } r -= I2;
        transpose_item(kp->in[32], DFF, 1024, (bf16_t*)(ws + WS_W_DN1), 0, scr, r, lane);
    }
}
constexpr int CV_L0A = 16 * 72 + 16 * 32;
constexpr int CV_L0B = CV_L0A + 16 * 176 + 44 * 32;
constexpr int CV_IN1 = CV_L0B + 16 * 33;
constexpr int CV_SMALL1 = CV_IN1 + 12 * 48 + 4 * 64 + 16 * 32;
constexpr int CV_UP1 = CV_SMALL1 + 16 * 176;
constexpr int CV_ALL = CV_UP1 + 44 * 32;
__device__ __forceinline__ void adaln_items(KP kp, unsigned char* ws, LAS unsigned char* lds, int tid, int lane, int wid, int lo, int hi, int brank, int nb) {
    float* MOD = (float*)(ws + WS_MOD);
    LAS float* SC = (LAS float*)(lds + 73728);
    LAS float* RED = (LAS float*)(lds + 73728 + 20480);
    { const float* cv = kp->in[1]; const float* ccv = kp->in[3];
      for (int i = tid; i < 5 * 1024; i += 512) { const int cnd = i >> 10, k = i & 1023; const float v = (cnd < 4) ? cv[cnd * 1024 + k] : ccv[k]; SC[i] = v / (1.f + expf(-v)); } }
    __syncthreads();
    for (int item = lo + brank; item < hi; item += nb) {
        const int l = item / 192, chunk = item % 192; const float* W = l ? kp->in[19] : kp->in[4]; const float* Bv = l ? kp->in[20] : kp->in[5];
        const int col = chunk * 32 + (lane & 31), kg16 = wid * 2 + (lane >> 5);
        float a0 = 0.f, a1 = 0.f, a2 = 0.f, a3 = 0.f, a4 = 0.f;
        for (int kb = 0; kb < 64; kb += 32) {
            float wv[32];
#pragma unroll
            for (int i = 0; i < 32; ++i) wv[i] = W[(size_t)(kg16 + 16 * (kb + i)) * 6144 + col];
#pragma unroll
            for (int i = 0; i < 32; ++i) { const int k = kg16 + 16 * (kb + i); const float w = wv[i];
                a0 += SC[k] * w; a1 += SC[1024 + k] * w; a2 += SC[2048 + k] * w; a3 += SC[3072 + k] * w; a4 += SC[4096 + k] * w; }
        }
        RED[(kg16 * 5 + 0) * 32 + (lane & 31)] = a0; RED[(kg16 * 5 + 1) * 32 + (lane & 31)] = a1; RED[(kg16 * 5 + 2) * 32 + (lane & 31)] = a2; RED[(kg16 * 5 + 3) * 32 + (lane & 31)] = a3; RED[(kg16 * 5 + 4) * 32 + (lane & 31)] = a4;
        __syncthreads();
        if (tid < 160) { const int cnd = tid >> 5, cl = tid & 31; float s = 0.f;
#pragma unroll
            for (int kg = 0; kg < 16; ++kg) s += RED[(kg * 5 + cnd) * 32 + cl];
            MOD[(size_t)(l * 5 + cnd) * 6144 + chunk * 32 + cl] = s + Bv[chunk * 32 + cl]; }
        __syncthreads();
    }
}
__device__ __forceinline__ bool idle_rank(int nwg, int G, int bx, int& rank, int& n) {
    const int cmax = (nwg + G - 1) / G, nb2 = nwg - G * (cmax - 1);
    if (nb2 >= G) { rank = bx; n = G; return true; }
    rank = bx - nb2; n = G - nb2; return bx >= nb2;
}
#define PH_BEGIN \
    const KP kp = kargs(); unsigned char* const ws = kp->ws; (void)ws; \
    const int tid = otid(), lane = tid & 63, wid = __builtin_amdgcn_readfirstlane(tid >> 6); (void)lane; \
    const int G = gridDim.x, bx = blockIdx.x, gw = bx * 8 + wid, ngw = G * 8; (void)gw; (void)ngw;

__global__ void __launch_bounds__(512) mega_fwd(Params Pdummy) {
    extern __shared__ __attribute__((aligned(16))) unsigned char lds_raw[];
    LAS unsigned char* lds = (LAS unsigned char*)lds_raw;
    cg::grid_group grid = cg::this_grid();
    { volatile LAS unsigned* MISC = (volatile LAS unsigned*)(lds + XLDS_OFF + 8192);
      if (threadIdx.x < 32) MISC[threadIdx.x] = 0u;
      __syncthreads();
      if (threadIdx.x == 0) (void)xb_add(&((unsigned*)(kargs()->ws + WS_BAR))[XB_XCNT(xb_xcc_id())], 1u); }

    for (int rep0_ = 0; rep0_ < REP_P0; ++rep0_) {
        PH_BEGIN
        float2* ROPE0 = (float2*)(ws + WS_ROPE0); float2* ROPE1 = (float2*)(ws + WS_ROPE1); bf16_t* H = (bf16_t*)(ws + WS_H);
        adaln_items(kp, ws, lds, tid, lane, wid, 0, 192, bx, G);
        for (int gt = bx * 512 + tid; gt < 1536 + 129 * 128 + 224 * 128; gt += G * 512) {
          if (gt < 1024) { const int v = gt >> 4, k = gt & 15; const float inv = exp2f(-(float)k * (13.287712379549449f / 16.f)); const float a = (float)v * inv; ROPE0[gt] = make_float2(cosf(a), sinf(a)); }
          else if (gt < 1536) { const int i = gt - 1024, v = i >> 3, k = i & 7; const float inv = exp2f(-(float)k * (13.287712379549449f / 8.f)); const float a = (float)v * inv; ROPE1[i] = make_float2(cosf(a), sinf(a)); }
          else if (gt < 1536 + 129 * 128) {
            const int zi = gt - 1536; const int zr = zi >> 7, zc = zi & 127; bf16_t* rp = (zr == 0) ? (H - D) : (H + (size_t)(MT + zr - 1) * D); *(u32x4*)(rp + zc * 8) = (u32x4){0u, 0u, 0u, 0u}; }
          else {
            const int wi = gt - 1536 - 129 * 128; bf16_t* rp = (bf16_t*)(ws + WS_W_IN1) + (size_t)1056 * 1024; *(u32x4*)(rp + (size_t)wi * 8) = (u32x4){0u, 0u, 0u, 0u}; }
        }
        convert_items(kp, ws, lds, lane, wid, 0, CV_L0A, gw, ngw);
    }
    GRID_SYNC();
    if (kargs()->ws == nullptr) grid.sync();

    {
        PH_BEGIN
        const float* MOD = (const float*)(ws + WS_MOD); bf16_t* H = (bf16_t*)(ws + WS_H); const float* xin = kp->in[0]; const float* cin = kp->in[2];
        for (int row = gw; row < MT; row += ngw) {
            const int b = row / PB, p = row - b * PB; const int cond = (p < SEQ) ? b : 4;
            const float* src = (p < SEQ) ? xin + (size_t)(b * SEQ + p) * D : cin + (size_t)(b * CTXL + (p - SEQ)) * D;
            const float* mn = MOD + (size_t)cond * 6144;
#pragma unroll
            for (int j = 0; j < 4; ++j) { const int col = 4 * lane + 256 * j; const f32x4 x = *(const f32x4*)(src + col), sh = *(const f32x4*)(mn + col), sc = *(const f32x4*)(mn + 1024 + col);
                const f32x4 h = x * (sc + 1.f) + sh; u32x2 w; w.x = pk_bf16(h[0], h[1]); w.y = pk_bf16(h[2], h[3]); *(u32x2*)(H + (size_t)row * D + col) = w; }
        }
    }
    GRID_SYNC();

    {
        PH_BEGIN
        pg8::Gemm g{(const bf16_t*)(ws + WS_H), (const bf16_t*)(ws + WS_W_IN0), 1024, 256, 1024}; pg8::StaticOrder S; S.init(MT / 256, N_IN0 / 256, G, bx, 0);
        pg8::EpiQkv0 E{(bf16_t*)(ws + WS_RAW0), (bf16_t*)(ws + WS_KVC0), kp->in[7], kp->in[8], (const float2*)(ws + WS_ROPE0), (LAS float*)(lds + XLDS_OFF)};
        for (int rep_ = 0; rep_ < REP_GEMM; ++rep_) pg8::gemm_phase<pg8::EpiQkv0>(lds, g, S, E);
        { int rk_, n_; if (idle_rank((MT / 256) * (N_IN0 / 256), G, bx, rk_, n_)) convert_items(kp, ws, lds, lane, wid, CV_L0A, CV_L0B, rk_ * 8 + wid, n_ * 8); }
    }
    GRID_SYNC();

    {
        PH_BEGIN
        const bf16_t* RAW0 = (const bf16_t*)(ws + WS_RAW0); const bf16_t* KVC0 = (const bf16_t*)(ws + WS_KVC0); bf16_t* O0 = (bf16_t*)(ws + WS_O0); const float* rpb = kp->in[9];
        for (int rep_ = 0; rep_ < REP_ATT; ++rep_)
        for (int u = ((G & 7) == 0 ? (bx & 7) * (G >> 3) + (bx >> 3) : bx); u < 1088; u += G) {
            if (u < 512 || u >= 1024) {
                const bool isctx = u >= 1024;
                int b, qcol, hk, hv, ocol; size_t qrow; int t0;
                if (!isctx) { const int qblk = u & 15, hq = (u >> 4) & 7; b = u >> 7; qcol = hq * 64; hk = hq >> 2; hv = 2 + (hq >> 2); ocol = hq * 64; qrow = (size_t)b * PB + 256 * qblk; t0 = 0; }
                else { const int v = u - 1024; const int h16 = v & 15; b = v >> 4; qcol = (h16 < 8) ? h16 * 64 : 768 + (h16 - 8) * 64; hk = (h16 < 8) ? (h16 >> 2) : 4 + (h16 - 8);
                       hv = (h16 < 8) ? 2 + (h16 >> 2) : 12 + (h16 - 8); ocol = h16 * 64; qrow = (size_t)b * PB + SEQ; t0 = 64; }
                attn_unit<64, false>(lds, RAW0 + qrow * N_IN0 + qcol, N_IN0, KVC0 + (size_t)(b * 20 + hk) * PB * 64, 64, nullptr,
                                     KVC0 + (size_t)(b * 20 + hv) * PB * 64, 64, O0 + qrow * 1024 + ocol, t0, 68, 0, 0, 0, nullptr);
            } else {
                const int v = u - 512; const int qblk = v & 15, h = (v >> 4) & 7, b = v >> 7; const size_t rowb = (size_t)b * PB;
                const int r0 = 4 * qblk, lo = min(max(r0 - 4, 0), 56), hi_ex = min(max(r0 + 3 - 4, 0), 56) + 8;
                attn_unit<64, true>(lds, RAW0 + (rowb + 256 * qblk) * N_IN0 + 768 + h * 64, N_IN0, KVC0 + (size_t)(b * 20 + 4 + h) * PB * 64, 64, nullptr,
                                    KVC0 + (size_t)(b * 20 + 12 + h) * PB * 64, 64, O0 + (rowb + 256 * qblk) * 1024 + (8 + h) * 64, 64, 68, lo, hi_ex, r0, rpb + h * 465);
            }
        }
        { const int vcu = ((G & 7) == 0 ? (bx & 7) * (G >> 3) + (bx >> 3) : bx);
          if (G >= 128) { if (vcu >= 64) { adaln_items(kp, ws, lds, tid, lane, wid, 192, 384, vcu - 64, G - 64); } }
          else { adaln_items(kp, ws, lds, tid, lane, wid, 192, 384, bx, G); } }
    }
    GRID_SYNC();

    {
        PH_BEGIN
        pg8::Gemm g{(const bf16_t*)(ws + WS_O0), (const bf16_t*)(ws + WS_W_OUT0), 1024, 256, 1024}; pg8::StaticOrder S; S.init(64, 4, G, bx, 1);
        pg8::EpiStore E{(bf16_t*)(ws + WS_Y0), 1024, nullptr};
        for (int rep_ = 0; rep_ < REP_GEMM; ++rep_) pg8::gemm_phase<pg8::EpiStore>(lds, g, S, E);
    }
    GRID_SYNC();
    {
        PH_BEGIN
        const float* MOD = (const float*)(ws + WS_MOD);
        if (G >= 64) {
            if (bx < 16) {
                pg8::Gemm g{(const bf16_t*)(ws + WS_O0), (const bf16_t*)(ws + WS_W_OUT0), 1024, 256, 1024}; pg8::StaticOrder S; S.init(4, 4, 16, bx, 2);
                pg8::EpiStore E{(bf16_t*)(ws + WS_Y0), 1024, nullptr};
                pg8::gemm_phase<pg8::EpiStore>(lds, g, S, E);
                sub_barrier((unsigned*)(ws + WS_BAR) + 3584, 16u);
                ln_phase(kp->in[0], kp->in[2], kp->out, (float*)(ws + WS_XC), (const bf16_t*)(ws + WS_Y0), nullptr, MOD, 2, kp->in[11], kp->in[12], MOD, 3, (bf16_t*)(ws + WS_H), 2, bx * 8 + wid, 16 * 8, lane);
            } else
                ln_phase(kp->in[0], kp->in[2], kp->out, (float*)(ws + WS_XC), (const bf16_t*)(ws + WS_Y0), nullptr, MOD, 2, kp->in[11], kp->in[12], MOD, 3, (bf16_t*)(ws + WS_H), 0, (bx - 16) * 8 + wid, (G - 16) * 8, lane);
        } else {
            pg8::Gemm g{(const bf16_t*)(ws + WS_O0), (const bf16_t*)(ws + WS_W_OUT0), 1024, 256, 1024}; pg8::StaticOrder S; S.init(4, 4, G, bx, 2);
            pg8::EpiStore E{(bf16_t*)(ws + WS_Y0), 1024, nullptr};
            pg8::gemm_phase<pg8::EpiStore>(lds, g, S, E);
            GRID_SYNC();
            ln_phase(kp->in[0], kp->in[2], kp->out, (float*)(ws + WS_XC), (const bf16_t*)(ws + WS_Y0), nullptr, MOD, 2, kp->in[11], kp->in[12], MOD, 3, (bf16_t*)(ws + WS_H), 1, gw, ngw, lane);
        }
    }
    GRID_SYNC();
    {
        PH_BEGIN
        pg8::Gemm g{(const bf16_t*)(ws + WS_H) - D, (const bf16_t*)(ws + WS_W_UP0), 1024, 254, 1024}; pg8::StaticOrder S; S.init(69, 22, G, bx, 0);
        pg8::EpiConvGlu E{(bf16_t*)(ws + WS_U), kp->in[14], kp->in[15], (LAS float*)(lds + XLDS_OFF)};
        for (int rep_ = 0; rep_ < REP_GEMM * REP_UP; ++rep_) pg8::gemm_phase<pg8::EpiConvGlu>(lds, g, S, E);
    }
    GRID_SYNC();
    {
        PH_BEGIN
        pg8::Gemm g{(const bf16_t*)(ws + WS_U), (const bf16_t*)(ws + WS_W_DN0), DFF, 256, DFF}; pg8::StaticOrder S; S.init(64, 4, G, bx, 1);
        pg8::EpiStore E{(bf16_t*)(ws + WS_Y), 1024, nullptr};
        for (int rep_ = 0; rep_ < REP_GEMM; ++rep_) pg8::gemm_phase<pg8::EpiStore>(lds, g, S, E);
    }
    GRID_SYNC();
    {
        PH_BEGIN
        const float* MOD = (const float*)(ws + WS_MOD); float* XC = (float*)(ws + WS_XC);
        if (G >= 64) {
            if (bx < 32) {
                pg8::Gemm g{(const bf16_t*)(ws + WS_U), (const bf16_t*)(ws + WS_W_DN0), DFF / 2, 256, DFF}; pg8::StaticOrder S; S.init(4, 4, 32, bx, 2, 2);
                pg8::EpiStore E{(bf16_t*)(ws + WS_Y), 1024, (bf16_t*)(ws + WS_YB)};
                pg8::gemm_phase<pg8::EpiStore>(lds, g, S, E);
                sub_barrier((unsigned*)(ws + WS_BAR) + 3648, 32u);
                ln_phase(kp->out, XC, kp->out, XC, (const bf16_t*)(ws + WS_Y), (const bf16_t*)(ws + WS_YB), MOD, 5, kp->in[17], kp->in[18], MOD + 5 * 6144, 0, (bf16_t*)(ws + WS_H), 2, bx * 8 + wid, 32 * 8, lane);
            } else {
                ln_phase(kp->out, XC, kp->out, XC, (const bf16_t*)(ws + WS_Y), nullptr, MOD, 5, kp->in[17], kp->in[18], MOD + 5 * 6144, 0, (bf16_t*)(ws + WS_H), 0, (bx - 32) * 8 + wid, (G - 32) * 8, lane);
                convert_items(kp, ws, lds, lane, wid, CV_L0B, CV_IN1, (bx - 32) * 8 + wid, (G - 32) * 8);
                convert_items(kp, ws, lds, lane, wid, CV_UP1, CV_ALL, (bx - 32) * 8 + wid, (G - 32) * 8);
            }
        } else {
            pg8::Gemm g{(const bf16_t*)(ws + WS_U), (const bf16_t*)(ws + WS_W_DN0), DFF / 2, 256, DFF}; pg8::StaticOrder S; S.init(4, 4, G, bx, 2, 2);
            pg8::EpiStore E{(bf16_t*)(ws + WS_Y), 1024, (bf16_t*)(ws + WS_YB)};
            pg8::gemm_phase<pg8::EpiStore>(lds, g, S, E);
            convert_items(kp, ws, lds, lane, wid, CV_L0B, CV_IN1, gw, ngw); convert_items(kp, ws, lds, lane, wid, CV_UP1, CV_ALL, gw, ngw);
            GRID_SYNC();
            ln_phase(kp->out, XC, kp->out, XC, (const bf16_t*)(ws + WS_Y), nullptr, MOD, 5, kp->in[17], kp->in[18], MOD + 5 * 6144, 0, (bf16_t*)(ws + WS_H), 0, gw, ngw, lane);
            ln_phase(kp->out, XC, kp->out, XC, (const bf16_t*)(ws + WS_Y), (const bf16_t*)(ws + WS_YB), MOD, 5, kp->in[17], kp->in[18], MOD + 5 * 6144, 0, (bf16_t*)(ws + WS_H), 2, gw, ngw, lane);
        }
    }
    GRID_SYNC();

    {
        PH_BEGIN
        pg8::Gemm g{(const bf16_t*)(ws + WS_H), (const bf16_t*)(ws + WS_W_IN1), 1024 / KS_G5, 256, 1024}; pg8::StaticOrder S; S.init(MT / 256, N_IN1P / 256, G, bx, 0, KS_G5);
        pg8::EpiStore E{(bf16_t*)(ws + WS_RAW1), N_IN1P, (bf16_t*)(ws + WS_RAW1B)};
        for (int rep_ = 0; rep_ < REP_GEMM; ++rep_) pg8::gemm_phase<pg8::EpiStore>(lds, g, S, E);
        { int rk_, n_; if (idle_rank((MT / 256) * (N_IN1P / 256) * KS_G5, G, bx, rk_, n_)) convert_items(kp, ws, lds, lane, wid, CV_IN1, CV_UP1, rk_ * 8 + wid, n_ * 8); }
    }
    GRID_SYNC();
    {
        PH_BEGIN
        const bf16_t* RAW1 = (const bf16_t*)(ws + WS_RAW1); const bf16_t* RAW1B = (const bf16_t*)(ws + WS_RAW1B); bf16_t* CQ = (bf16_t*)(ws + WS_CQ); bf16_t* CKV = (bf16_t*)(ws + WS_CKV); bf16_t* KR = (bf16_t*)(ws + WS_KR);
        const float2* ROPE1 = (const float2*)(ws + WS_ROPE1);
        const float* cqg = kp->in[22]; const float* ckvg = kp->in[23];
        for (int row = gw; row < MT; row += ngw) {
            const int b = row / PB, p = row - b * PB; const bool lat = p < SEQ;
            const bf16_t* rp = RAW1 + (size_t)row * N_IN1P; const bf16_t* rp2 = RAW1B + (size_t)row * N_IN1P; (void)rp2;
#define LD8SUM(ARR, off) float ARR[8]; { const u32x4 w_ = *(const u32x4*)(rp + (off)); const u32x4 z_ = (KS_G5 > 1) ? *(const u32x4*)(rp2 + (off)) : (u32x4){0u, 0u, 0u, 0u}; \
                ARR[0] = bf_lo(w_[0]) + bf_lo(z_[0]); ARR[1] = bf_hi(w_[0]) + bf_hi(z_[0]); ARR[2] = bf_lo(w_[1]) + bf_lo(z_[1]); ARR[3] = bf_hi(w_[1]) + bf_hi(z_[1]); \
                ARR[4] = bf_lo(w_[2]) + bf_lo(z_[2]); ARR[5] = bf_hi(w_[2]) + bf_hi(z_[2]); ARR[6] = bf_lo(w_[3]) + bf_lo(z_[3]); ARR[7] = bf_hi(w_[3]) + bf_hi(z_[3]); }
            if (lat) {
                LD8SUM(xa, lane * 8) LD8SUM(xb, 512 + (lane & 31) * 8)
                float ss = 0.f;
#pragma unroll
                for (int t = 0; t < 8; ++t) { ss += xa[t] * xa[t]; if (lane < 32) ss += xb[t] * xb[t]; }
                const float rstd = 1.f / sqrtf(wave_sum(ss) * (1.f / 768.f) + EPSF);
                { const f32x4 g0 = *(const f32x4*)(cqg + lane * 8), g1 = *(const f32x4*)(cqg + lane * 8 + 4);
                  u32x4 o; o.x = pk_bf16(xa[0] * rstd * g0[0], xa[1] * rstd * g0[1]); o.y = pk_bf16(xa[2] * rstd * g0[2], xa[3] * rstd * g0[3]);
                  o.z = pk_bf16(xa[4] * rstd * g1[0], xa[5] * rstd * g1[1]); o.w = pk_bf16(xa[6] * rstd * g1[2], xa[7] * rstd * g1[3]);
                  *(u32x4*)(CQ + (size_t)row * QLORA + lane * 8) = o; }
                if (lane < 32) { const f32x4 g0 = *(const f32x4*)(cqg + 512 + lane * 8), g1 = *(const f32x4*)(cqg + 512 + lane * 8 + 4);
                  u32x4 o; o.x = pk_bf16(xb[0] * rstd * g0[0], xb[1] * rstd * g0[1]); o.y = pk_bf16(xb[2] * rstd * g0[2], xb[3] * rstd * g0[3]);
                  o.z = pk_bf16(xb[4] * rstd * g1[0], xb[5] * rstd * g1[1]); o.w = pk_bf16(xb[6] * rstd * g1[2], xb[7] * rstd * g1[3]);
                  *(u32x4*)(CQ + (size_t)row * QLORA + 512 + lane * 8) = o; }
            }
            {
                const int l32 = lane & 31;
                LD8SUM(x, 768 + l32 * 8)
                float ss = 0.f;
#pragma unroll
                for (int t = 0; t < 8; ++t) ss += x[t] * x[t];
                const float rstd = 1.f / sqrtf(wave_sum(ss) * (0.5f / 256.f) + EPSF);
                const f32x4 g0 = *(const f32x4*)(ckvg + l32 * 8), g1 = *(const f32x4*)(ckvg + l32 * 8 + 4);
                u32x4 o; o.x = pk_bf16(x[0] * rstd * g0[0], x[1] * rstd * g0[1]); o.y = pk_bf16(x[2] * rstd * g0[2], x[3] * rstd * g0[3]);
                o.z = pk_bf16(x[4] * rstd * g1[0], x[5] * rstd * g1[1]); o.w = pk_bf16(x[6] * rstd * g1[2], x[7] * rstd * g1[3]);
                if (lane < 32) *(u32x4*)(CKV + (size_t)row * KVLORA + l32 * 8) = o;
            }
            if (lane < 4) {
                LD8SUM(x, 1024 + lane * 8)
                const int pos = (lane < 2) ? (p >> 6) : (p & 63); const int kb = (4 * lane) & 7;
                unsigned ow[4];
#pragma unroll
                for (int t = 0; t < 4; ++t) { const float2 cs = lat ? ROPE1[pos * 8 + kb + t] : make_float2(1.f, 0.f); const float x1 = x[2 * t], x2 = x[2 * t + 1];
                    ow[t] = pk_bf16(x1 * cs.x - x2 * cs.y, x1 * cs.y + x2 * cs.x); }
                *(u32x4*)(KR + (size_t)row * 32 + lane * 8) = (u32x4){ow[0], ow[1], ow[2], ow[3]};
            }
        }
    }
    GRID_SYNC();
    {
        PH_BEGIN
        pg8::Gemm g{(const bf16_t*)(ws + WS_CQ), (const bf16_t*)(ws + WS_W_UQ), QLORA, 256, QLORA}; pg8::StaticOrder S; S.init(64, NQ1 / 256, G, bx, 1);
        pg8::EpiUq E{(bf16_t*)(ws + WS_Q1), (const float2*)(ws + WS_ROPE1)};
        for (int rep_ = 0; rep_ < REP_GEMM; ++rep_) pg8::gemm_phase<pg8::EpiUq>(lds, g, S, E);
    }
    {
        PH_BEGIN
        pg8::Gemm g{(const bf16_t*)(ws + WS_CKV), (const bf16_t*)(ws + WS_W_UKV), KVLORA, 256, KVLORA}; pg8::StaticOrder S;
        if ((G & 1) == 0 && G >= 64) { const int hG = G >> 1; if (bx < hG) { S.init(MT / 256, NKV1 / 256, hG, bx, 0); S.u0 = 0; S.u1 = hG; } else { S.init(MT / 256, NKV1 / 256, hG, bx - hG, 0); S.u0 = hG; } }
        else S.init(MT / 256, NKV1 / 256, G, G - 1 - bx, 0);
        pg8::EpiHeads E{(bf16_t*)(ws + WS_KV1), 32};
        for (int rep_ = 0; rep_ < REP_GEMM; ++rep_) pg8::gemm_phase<pg8::EpiHeads>(lds, g, S, E);
    }
    GRID_SYNC();
    {
        PH_BEGIN
        const bf16_t* Q1 = (const bf16_t*)(ws + WS_Q1); const bf16_t* KV1 = (const bf16_t*)(ws + WS_KV1); const bf16_t* KR = (const bf16_t*)(ws + WS_KR);
        bf16_t* O1 = (bf16_t*)(ws + WS_O1);
        for (int rep_ = 0; rep_ < REP_ATT; ++rep_)
        for (int u = ((G & 7) == 0 ? (bx & 7) * (G >> 3) + (bx >> 3) : bx); u < 1024; u += G) {
            const int qblk = u & 15, h = (u >> 4) & 15, b = u >> 8; const size_t rowb = (size_t)b * PB;
            attn_unit<96, false>(lds, Q1 + (rowb + 256 * qblk) * NQ1 + h * 96, NQ1, KV1 + (size_t)(b * 32 + 2 * h) * PB * 64, 64, KR + rowb * 32,
                                 KV1 + (size_t)(b * 32 + 2 * h + 1) * PB * 64, 64, O1 + (rowb + 256 * qblk) * 1024 + h * 64, 0, 68, 0, 0, 0, nullptr);
        }
    }
    GRID_SYNC();
    {
        PH_BEGIN
        pg8::Gemm g{(const bf16_t*)(ws + WS_O1), (const bf16_t*)(ws + WS_W_OUT1), 1024, 256, 1024}; pg8::StaticOrder S; S.init(64, 4, G, bx, 1);
        pg8::EpiStore E{(bf16_t*)(ws + WS_Y1), 1024, nullptr};
        for (int rep_ = 0; rep_ < REP_GEMM; ++rep_) pg8::gemm_phase<pg8::EpiStore>(lds, g, S, E);
    }
    GRID_SYNC();
    {
        PH_BEGIN
        const float* MOD1 = (const float*)(ws + WS_MOD) + 5 * 6144; float* XC = (float*)(ws + WS_XC);
        ln_phase(kp->out, XC, kp->out, XC, (const bf16_t*)(ws + WS_Y1), nullptr, MOD1, 2, kp->in[27], kp->in[28], MOD1, 3, (bf16_t*)(ws + WS_H), 0, gw, ngw, lane);
    }
    GRID_SYNC();
    {
        PH_BEGIN
        pg8::Gemm g{(const bf16_t*)(ws + WS_H) - D, (const bf16_t*)(ws + WS_W_UP1), 1024, 254, 1024}; pg8::StaticOrder S; S.init(69, 22, G, bx, 0);
        pg8::EpiConvGlu E{(bf16_t*)(ws + WS_U), kp->in[30], kp->in[31], (LAS float*)(lds + XLDS_OFF)};
        for (int rep_ = 0; rep_ < REP_GEMM * REP_UP; ++rep_) pg8::gemm_phase<pg8::EpiConvGlu>(lds, g, S, E);
    }
    GRID_SYNC();
    {
        PH_BEGIN
        pg8::Gemm g{(const bf16_t*)(ws + WS_U), (const bf16_t*)(ws + WS_W_DN1), DFF, 256, DFF}; pg8::StaticOrder S; S.init(64, 4, G, bx, 1);
        pg8::EpiStore E{(bf16_t*)(ws + WS_Y), 1024, nullptr};
        for (int rep_ = 0; rep_ < REP_GEMM; ++rep_) pg8::gemm_phase<pg8::EpiStore>(lds, g, S, E);
    }
    GRID_SYNC();
    {
        PH_BEGIN
        const float* MOD1 = (const float*)(ws + WS_MOD) + 5 * 6144; float* XC = (float*)(ws + WS_XC);
        ln_phase(kp->out, XC, kp->out, XC, (const bf16_t*)(ws + WS_Y), nullptr, MOD1, 5, kp->in[33], kp->in[34], nullptr, 0, (bf16_t*)(ws + WS_H), 0, gw, ngw, lane);
    }
}

extern "C" void kernel_launch(void* const* d_in, const int* in_sizes, int n_in, void* d_out, int out_size, void* d_ws, size_t ws_size, hipStream_t stream) {
    static int grid_blocks = 0;
    if (grid_blocks == 0) {
        if (n_in != 35 || ws_size < WS_END) { fprintf(stderr, "kernel_launch: unexpected n_in %d / ws %zu\n", n_in, ws_size); grid_blocks = -1; return; }
        int dev = 0, cus = 0, per_cu = 0;
        hipGetDevice(&dev);
        hipDeviceGetAttribute(&cus, hipDeviceAttributeMultiprocessorCount, dev);
        if (hipFuncSetAttribute((const void*)mega_fwd, hipFuncAttributeMaxDynamicSharedMemorySize, LDS_BYTES) != hipSuccess) { fprintf(stderr, "kernel_launch: hipFuncSetAttribute failed\n"); }
        if (hipOccupancyMaxActiveBlocksPerMultiprocessor(&per_cu, (const void*)mega_fwd, 512, LDS_BYTES) != hipSuccess || per_cu < 1) { fprintf(stderr, "kernel_launch: occupancy query gave %d\n", per_cu); per_cu = 1; }
        (void)hipGetLastError();
        if (per_cu > 1) per_cu = 1;
        grid_blocks = cus * per_cu;
    }
    if (grid_blocks < 0) return;
    Params p{};
    for (int i = 0; i < 35; ++i) p.in[i] = (const float*)d_in[i];
    p.out = (float*)d_out; p.ws = (unsigned char*)d_ws;
    if (hipMemsetAsync((unsigned char*)d_ws + WS_BAR, 0, 16 * KiB, stream) != hipSuccess) { fprintf(stderr, "kernel_launch: memset of barrier words failed\n"); return; }
    void* args[] = {&p};
    hipError_t e = hipLaunchCooperativeKernel((const void*)mega_fwd, dim3(grid_blocks), dim3(512), args, LDS_BYTES, stream);
    if (e != hipSuccess) fprintf(stderr, "cooperative launch failed: %s (grid %d)\n", hipGetErrorString(e), grid_blocks);
}
```
